# Optimizing an MI355X kernel written in HIP

```python
import jax, jax.numpy as jnp
from jax import lax
import numpy as np

D_MODEL = 2048
BATCH = 1
SEQ = 16384
DEPTH = 2

N_EVEN = (DEPTH + 1) // 2
N_ODD = DEPTH // 2
NORM_EPS = 1e-6
NEG_INF = -1e30
ROPE_THETA = 10000.0
D_FF = 4 * D_MODEL

NSA_HEADS = 8
NSA_KV_HEADS = 2
NSA_GROUP = NSA_HEADS // NSA_KV_HEADS
NSA_DH = 128
CMP_LEN = 32
CMP_STRIDE = 16
SLC_LEN = 64
SLC_TOPN = 16
WIN = 512
Q_BLOCK = 128
SLC_FORCE = 1e4
NSA_W = NSA_HEADS * NSA_DH
NSA_KV_W = NSA_KV_HEADS * NSA_DH
NSA_COLS = NSA_W + 6 * NSA_KV_W + 3 * NSA_HEADS

RW_HEADS = 16
RW_DH = 64
RW_W = RW_HEADS * RW_DH
RW_DECAY_LORA = 96
RW_A_LORA = 96
RW_G_LORA = 256
RW_LNX_EPS = 64e-5
RW_COLS = 3 * RW_W + RW_DECAY_LORA + RW_A_LORA + RW_G_LORA

LRU_W = 1024
LRU_BLOCKS = 8
LRU_BW = LRU_W // LRU_BLOCKS
CONV_W = 4
LRU_C = 8.0

HG_HEADS = 8
HG_DK = 128
HG_DV = 128
HG_KW = HG_HEADS * HG_DK
HG_VW = HG_HEADS * HG_DV
HG_CHUNK = 64

EVEN_COLS = NSA_COLS + RW_COLS
ODD_COLS = 2 * LRU_W + 2 * HG_KW + 2 * HG_VW
MIX_EVEN = NSA_W + RW_W
MIX_ODD = LRU_W + HG_VW

kernel_name = 'hybrid_nsa_rwkv7_rglru_hgrn2_trunk'


def _split(h, sizes):
    cuts = [int(c) for c in np.cumsum(sizes)[:-1]]
    return jnp.split(h, cuts, axis=-1)


def _rms_norm(x, g, eps=NORM_EPS):
    xf = x.astype(jnp.float32)
    y = xf * lax.rsqrt(jnp.mean(xf * xf, axis=-1, keepdims=True) + eps)
    return (y * g.astype(jnp.float32)).astype(x.dtype)


def _rope_tables(pos):
    inv = ROPE_THETA ** (-(jnp.arange(0, NSA_DH, 2, dtype=jnp.float32) / NSA_DH))
    ang = pos[:, None] * inv[None, :]
    return jnp.cos(ang), jnp.sin(ang)


def _apply_rope(x, cos, sin):
    xf = x.astype(jnp.float32)
    half = xf.shape[-1] // 2
    x1, x2 = xf[..., :half], xf[..., half:]
    c, s = cos[None, :, None, :], sin[None, :, None, :]
    return jnp.concatenate([x1 * c - x2 * s, x1 * s + x2 * c], axis=-1).astype(x.dtype)


def _masked_softmax(s, mask):
    p = jax.nn.softmax(jnp.where(mask, s, NEG_INF), axis=-1)
    return p * mask


def _compress(t, w, pe):
    B, S, G, dh = t.shape
    chunks = t.reshape(B, S // CMP_STRIDE, CMP_STRIDE, G, dh)
    blocks = jnp.concatenate([chunks[:, :-1], chunks[:, 1:]], axis=2)
    blocks = blocks + pe[None, None, :, None, :]
    return jnp.einsum('bnlgd,lde->bnge', blocks, w)


def _nsa(u, qk_gain, cmp_w, cmp_pe, cos, sin):
    B, S, _ = u.shape
    f32 = jnp.float32
    q, kc, vc, ks, vs, kw, vw, gate = _split(u, [NSA_W] + [NSA_KV_W] * 6 + [3 * NSA_HEADS])
    q = q.reshape(B, S, NSA_HEADS, NSA_DH)
    kc, vc, ks, vs, kw, vw = (t.reshape(B, S, NSA_KV_HEADS, NSA_DH) for t in (kc, vc, ks, vs, kw, vw))
    n_cmp = (S - CMP_LEN) // CMP_STRIDE + 1
    n_slc = S // SLC_LEN
    n_qb = S // Q_BLOCK
    top_n = min(SLC_TOPN, n_slc)
    scale = NSA_DH ** -0.5

    q = _apply_rope(_rms_norm(q, qk_gain[0]), cos, sin)
    ks = _apply_rope(_rms_norm(ks, qk_gain[2]), cos, sin)
    kw = _apply_rope(_rms_norm(kw, qk_gain[3]), cos, sin)
    kcmp = _compress(kc, cmp_w[0], cmp_pe[0])
    vcmp = _compress(vc, cmp_w[1], cmp_pe[1])
    cmp_end = jnp.arange(n_cmp) * CMP_STRIDE + CMP_LEN - 1
    ccos, csin = _rope_tables(cmp_end.astype(f32))
    kcmp = _apply_rope(_rms_norm(kcmp, qk_gain[1]), ccos, csin)

    c0 = jnp.arange(n_cmp)[:, None] * CMP_STRIDE
    s0 = jnp.arange(n_slc)[None, :] * SLC_LEN
    overlap = jnp.clip(jnp.minimum(c0 + CMP_LEN, s0 + SLC_LEN) - jnp.maximum(c0, s0), 0, None).astype(f32) / CMP_LEN

    ks_blk = ks.reshape(B, n_slc, SLC_LEN, NSA_KV_HEADS, NSA_DH).transpose(0, 3, 1, 2, 4)
    vs_blk = vs.reshape(B, n_slc, SLC_LEN, NSA_KV_HEADS, NSA_DH).transpose(0, 3, 1, 2, 4)
    kw_pad = jnp.pad(kw, ((0, 0), (WIN, 0), (0, 0), (0, 0)))
    vw_pad = jnp.pad(vw, ((0, 0), (WIN, 0), (0, 0), (0, 0)))
    gather = jax.vmap(jax.vmap(lambda blk, idx: blk[idx]))

    q_blocks = q.reshape(B, n_qb, Q_BLOCK, NSA_KV_HEADS, NSA_GROUP, NSA_DH).transpose(1, 0, 2, 3, 4, 5)
    g_all = jax.nn.sigmoid(gate.astype(f32)).reshape(B, n_qb, Q_BLOCK, 3, NSA_KV_HEADS, NSA_GROUP)
    g_blocks = g_all.transpose(1, 0, 2, 3, 4, 5)
    slc_ids = jnp.arange(n_slc)

    def block_fn(args):
        qb, gb, blk = args
        t = blk * Q_BLOCK + jnp.arange(Q_BLOCK)
        s = jnp.einsum('bqgjd,bngd->bgjqn', qb, kcmp).astype(f32) * scale
        p = _masked_softmax(s, cmp_end[None, :] <= t[:, None])
        o_c = jnp.einsum('bgjqn,bngd->bqgjd', p.astype(vcmp.dtype), vcmp)
        imp = jnp.einsum('bgjqn,nm->bgqm', p, overlap)
        cur = t // SLC_LEN
        forced = (slc_ids[None, :] == 0) | (slc_ids[None, :] == cur[:, None]) | (slc_ids[None, :] == cur[:, None] - 1)
        valid = slc_ids[None, :] <= cur[:, None]
        score = jnp.where(forced, SLC_FORCE, jnp.where(valid, imp, -1.0))
        _, idx = lax.top_k(score, top_n)
        kg = gather(ks_blk, idx).reshape(B, NSA_KV_HEADS, Q_BLOCK, top_n * SLC_LEN, NSA_DH)
        vg = gather(vs_blk, idx).reshape(B, NSA_KV_HEADS, Q_BLOCK, top_n * SLC_LEN, NSA_DH)
        kpos = (idx[..., None] * SLC_LEN + jnp.arange(SLC_LEN)).reshape(B, NSA_KV_HEADS, Q_BLOCK, top_n * SLC_LEN)
        s = jnp.einsum('bqgjd,bgqkd->bgjqk', qb, kg).astype(f32) * scale
        p = _masked_softmax(s, (kpos <= t[None, None, :, None])[:, :, None])
        o_s = jnp.einsum('bgjqk,bgqkd->bqgjd', p.astype(vg.dtype), vg)
        kwb = lax.dynamic_slice_in_dim(kw_pad, blk * Q_BLOCK, WIN + Q_BLOCK, axis=1)
        vwb = lax.dynamic_slice_in_dim(vw_pad, blk * Q_BLOCK, WIN + Q_BLOCK, axis=1)
        wpos = blk * Q_BLOCK - WIN + jnp.arange(WIN + Q_BLOCK)
        d = t[:, None] - wpos[None, :]
        mw = (d >= 0) & (d < WIN) & (wpos[None, :] >= 0)
        s = jnp.einsum('bqgjd,bkgd->bgjqk', qb, kwb).astype(f32) * scale
        p = _masked_softmax(s, mw)
        o_w = jnp.einsum('bgjqk,bkgd->bqgjd', p.astype(vwb.dtype), vwb)
        o = (gb[:, :, 0, :, :, None] * o_c.astype(f32) + gb[:, :, 1, :, :, None] * o_s.astype(f32)
             + gb[:, :, 2, :, :, None] * o_w.astype(f32))
        return o.astype(qb.dtype)

    o = lax.map(block_fn, (q_blocks, g_blocks, jnp.arange(n_qb)))
    return o.transpose(1, 0, 2, 3, 4, 5).reshape(B, S, NSA_W)


def _rwkv7_scan(r, w, k, v, a, b):
    B, S, H, N = r.shape

    def step(state, inp):
        r_t, w_t, k_t, v_t, a_t, b_t = inp
        sa = jnp.einsum('bhij,bhj->bhi', state, a_t)
        state = state * w_t[:, :, None, :] + sa[..., None] * b_t[:, :, None, :] + v_t[..., None] * k_t[:, :, None, :]
        return state, jnp.einsum('bhij,bhj->bhi', state, r_t)

    xs = tuple(jnp.moveaxis(t, 1, 0) for t in (r, w, k, v, a, b))
    _, y = lax.scan(step, jnp.zeros((B, H, N, N), jnp.float32), xs)
    return jnp.moveaxis(y, 0, 1)


def _rwkv7(u, mu, w0, w2, a0, a2, g2, k_k, k_a, r_k, lnx_w, lnx_b):
    B, S, _ = u.shape
    f32 = jnp.float32
    u_prev = jnp.pad(u, ((0, 0), (1, 0), (0, 0)))[:, :-1]
    u = u + (u_prev - u) * mu
    r, k, v, wl, al, gl = _split(u, [RW_W, RW_W, RW_W, RW_DECAY_LORA, RW_A_LORA, RW_G_LORA])
    w = -jax.nn.softplus(-(w0 + jnp.tanh(wl) @ w2).astype(f32)) - 0.5
    decay = jnp.exp(-jnp.exp(w))
    a = jax.nn.sigmoid((a0 + al @ a2).astype(f32))
    g = (jax.nn.sigmoid(gl) @ g2).astype(f32)
    kf = k.astype(f32)
    kk = (kf * k_k.astype(f32)).reshape(B, S, RW_HEADS, RW_DH)
    kk = kk / jnp.maximum(jnp.sqrt(jnp.sum(kk * kk, axis=-1, keepdims=True)), 1e-12)
    kf = kf * (1.0 + (a - 1.0) * k_a.astype(f32))
    heads = lambda t: t.reshape(B, S, RW_HEADS, RW_DH)
    rh, kh, vh, ah, dh_ = heads(r.astype(f32)), heads(kf), heads(v.astype(f32)), heads(a), heads(decay)
    y = _rwkv7_scan(rh, dh_, kh, vh, -kk, kk * ah)
    mean = jnp.mean(y, axis=-1, keepdims=True)
    var = jnp.mean(jnp.square(y - mean), axis=-1, keepdims=True)
    y = ((y - mean) * lax.rsqrt(var + RW_LNX_EPS)).reshape(B, S, RW_W) * lnx_w.astype(f32) + lnx_b.astype(f32)
    bonus = jnp.sum(rh * kh * r_k.astype(f32), axis=-1, keepdims=True) * vh
    y = (y + bonus.reshape(B, S, RW_W)) * g
    return y.astype(u.dtype)


def _rglru(u, conv_w, conv_b, wa, ba, wx, bx, lam):
    B, S, _ = u.shape
    f32 = jnp.float32
    gate_in, xb = _split(u, [LRU_W, LRU_W])
    xc = lax.conv_general_dilated(xb, conv_w[:, None, :], window_strides=(1,), padding=[(CONV_W - 1, 0)],
                                  dimension_numbers=('NWC', 'WIO', 'NWC'), feature_group_count=LRU_W) + conv_b
    blocks = xc.reshape(B, S, LRU_BLOCKS, LRU_BW)
    r = jax.nn.sigmoid(jnp.einsum('bsnc,ncd->bsnd', blocks, wa).reshape(B, S, LRU_W).astype(f32) + ba.astype(f32))
    i = jax.nn.sigmoid(jnp.einsum('bsnc,ncd->bsnd', blocks, wx).reshape(B, S, LRU_W).astype(f32) + bx.astype(f32))
    log_a = -LRU_C * r * jax.nn.softplus(-lam.astype(f32))
    a = jnp.exp(log_a)
    b = jnp.sqrt(-jnp.expm1(2.0 * log_a)) * i * xc.astype(f32)

    def combine(lhs, rhs):
        a1, b1 = lhs
        a2, b2 = rhs
        return a1 * a2, a2 * b1 + b2

    _, h = lax.associative_scan(combine, (a, b), axis=1)
    return (h * jax.nn.gelu(gate_in.astype(f32))).astype(u.dtype)


def _hgrn2_chunkwise(q, k, v, log_f):
    B, S, H, dk = q.shape
    dv = v.shape[-1]
    n_chunk = S // HG_CHUNK

    def chunks(t):
        return t.reshape(B, n_chunk, HG_CHUNK, H, t.shape[-1]).transpose(1, 0, 3, 2, 4)

    tri = jnp.tril(jnp.ones((HG_CHUNK, HG_CHUNK), dtype=bool))

    def step(state, inp):
        qc, kc, vc, lc = inp
        bcum = jnp.cumsum(lc, axis=2)
        o = jnp.einsum('bhtk,bhkv->bhtv', qc * jnp.exp(bcum), state)
        diff = bcum[:, :, :, None, :] - bcum[:, :, None, :, :]
        decay = jnp.exp(jnp.where(tri[:, :, None], diff, NEG_INF))
        att = jnp.einsum('bhtk,bhsk,bhtsk->bhts', qc, kc, decay)
        o = o + jnp.einsum('bhts,bhsv->bhtv', att, vc)
        b_last = bcum[:, :, -1:, :]
        state = (jnp.exp(b_last[:, :, 0, :])[..., None] * state
                 + jnp.einsum('bhsk,bhsv->bhkv', kc * jnp.exp(b_last - bcum), vc))
        return state, o

    s0 = jnp.zeros((B, H, dk, dv), jnp.float32)
    _, o = lax.scan(step, s0, (chunks(q), chunks(k), chunks(v), chunks(log_f)))
    return o.transpose(1, 0, 3, 2, 4).reshape(B, S, H, dv)


def _hgrn2(u, lower, norm_g):
    B, S, _ = u.shape
    f32 = jnp.float32
    q, f, i, g = _split(u, [HG_KW, HG_KW, HG_VW, HG_VW])
    forget = lower + (1.0 - lower) * jax.nn.sigmoid(f.astype(f32))
    qh = jax.nn.silu(q.astype(f32)).reshape(B, S, HG_HEADS, HG_DK)
    kh = (1.0 - forget).reshape(B, S, HG_HEADS, HG_DK)
    lh = jnp.log(forget).reshape(B, S, HG_HEADS, HG_DK)
    vh = i.astype(f32).reshape(B, S, HG_HEADS, HG_DV)
    o = _hgrn2_chunkwise(qh, kh, vh, lh)
    o = _rms_norm(o, norm_g.reshape(HG_HEADS, HG_DV)).reshape(B, S, HG_VW)
    return (o * jax.nn.silu(g.astype(f32))).astype(u.dtype)


def _sq_relu_mlp(h, w1, w2):
    z = jax.nn.relu(h @ w1)
    return (z * z) @ w2


def setup_inputs(seed: int = 0) -> dict:
    key = jax.random.key(seed)
    keys = iter(jax.random.split(key, 48))
    f32 = jnp.float32

    def normal(shape, scale):
        return jax.random.normal(next(keys), shape, f32) * scale

    def gain(shape):
        return 1.0 + 0.02 * jax.random.normal(next(keys), shape, f32)

    def uniform(shape, lo, hi):
        return jax.random.uniform(next(keys), shape, f32, lo, hi)

    a_base = uniform((N_ODD, LRU_W), 0.9, 0.999) ** (1.0 / LRU_C)
    lam = jnp.log(a_base) - jnp.log1p(-a_base)
    return {
        'x': normal((BATCH, SEQ, D_MODEL), 1.0),
        'norm_mix': gain((DEPTH, D_MODEL)),
        'norm_mlp': gain((DEPTH, D_MODEL)),
        'w_ff1': normal((DEPTH, D_MODEL, D_FF), D_MODEL ** -0.5),
        'w_ff2': normal((DEPTH, D_FF, D_MODEL), D_FF ** -0.5),
        'w_in_a': normal((N_EVEN, D_MODEL, EVEN_COLS), D_MODEL ** -0.5),
        'w_out_a': normal((N_EVEN, MIX_EVEN, D_MODEL), MIX_EVEN ** -0.5),
        'nsa_qk_gain': gain((N_EVEN, 4, NSA_DH)),
        'nsa_cmp_w': normal((N_EVEN, 2, CMP_LEN, NSA_DH, NSA_DH), (CMP_LEN * NSA_DH) ** -0.5),
        'nsa_cmp_pe': normal((N_EVEN, 2, CMP_LEN, NSA_DH), 0.1),
        'rw_mu': uniform((N_EVEN, RW_COLS), 0.0, 1.0),
        'rw_w0': uniform((N_EVEN, RW_W), -6.0, -1.0),
        'rw_w2': normal((N_EVEN, RW_DECAY_LORA, RW_W), 0.5 * RW_DECAY_LORA ** -0.5),
        'rw_a0': normal((N_EVEN, RW_W), 0.1),
        'rw_a2': normal((N_EVEN, RW_A_LORA, RW_W), 0.5 * RW_A_LORA ** -0.5),
        'rw_g2': normal((N_EVEN, RW_G_LORA, RW_W), RW_G_LORA ** -0.5),
        'rw_k_k': 0.85 + normal((N_EVEN, RW_W), 0.02),
        'rw_k_a': gain((N_EVEN, RW_W)),
        'rw_r_k': normal((N_EVEN, RW_HEADS, RW_DH), 0.1),
        'rw_lnx_w': gain((N_EVEN, RW_W)),
        'rw_lnx_b': normal((N_EVEN, RW_W), 0.01),
        'w_in_b': normal((N_ODD, D_MODEL, ODD_COLS), D_MODEL ** -0.5),
        'w_out_b': normal((N_ODD, MIX_ODD, D_MODEL), MIX_ODD ** -0.5),
        'lru_conv_w': normal((N_ODD, CONV_W, LRU_W), CONV_W ** -0.5),
        'lru_conv_b': normal((N_ODD, LRU_W), 0.01),
        'lru_wa': normal((N_ODD, LRU_BLOCKS, LRU_BW, LRU_BW), LRU_BW ** -0.5),
        'lru_ba': normal((N_ODD, LRU_W), 0.01),
        'lru_wx': normal((N_ODD, LRU_BLOCKS, LRU_BW, LRU_BW), LRU_BW ** -0.5),
        'lru_bx': normal((N_ODD, LRU_W), 0.01),
        'lru_lambda': lam,
        'hg_lb': normal((DEPTH, HG_KW), 1.0),
        'hg_norm': gain((N_ODD, HG_VW)),
    }


def reference(x, norm_mix, norm_mlp, w_ff1, w_ff2, w_in_a, w_out_a, nsa_qk_gain, nsa_cmp_w, nsa_cmp_pe,
              rw_mu, rw_w0, rw_w2, rw_a0, rw_a2, rw_g2, rw_k_k, rw_k_a, rw_r_k, rw_lnx_w, rw_lnx_b,
              w_in_b, w_out_b, lru_conv_w, lru_conv_b, lru_wa, lru_ba, lru_wx, lru_bx, lru_lambda,
              hg_lb, hg_norm):
    B, S, _ = x.shape
    cos, sin = _rope_tables(jnp.arange(S, dtype=jnp.float32))
    lb_p = jax.nn.softmax(hg_lb.astype(jnp.float32), axis=0)
    lb_cum = jnp.cumsum(lb_p, axis=0)
    hg_lower = lb_cum - lb_cum[0:1]
    for layer in range(DEPTH):
        h = _rms_norm(x, norm_mix[layer])
        if layer % 2 == 0:
            e = layer // 2
            u = h @ w_in_a[e]
            u_nsa, u_rw = _split(u, [NSA_COLS, RW_COLS])
            y_a = _nsa(u_nsa, nsa_qk_gain[e], nsa_cmp_w[e], nsa_cmp_pe[e], cos, sin)
            y_b = _rwkv7(u_rw, rw_mu[e], rw_w0[e], rw_w2[e], rw_a0[e], rw_a2[e], rw_g2[e],
                         rw_k_k[e], rw_k_a[e], rw_r_k[e], rw_lnx_w[e], rw_lnx_b[e])
            y = jnp.concatenate([y_a, y_b], axis=-1) @ w_out_a[e]
        else:
            o = layer // 2
            u = h @ w_in_b[o]
            u_lru, u_hg = _split(u, [2 * LRU_W, 2 * HG_KW + 2 * HG_VW])
            y_c = _rglru(u_lru, lru_conv_w[o], lru_conv_b[o], lru_wa[o], lru_ba[o], lru_wx[o], lru_bx[o], lru_lambda[o])
            y_d = _hgrn2(u_hg, hg_lower[layer], hg_norm[o])
            y = jnp.concatenate([y_c, y_d], axis=-1) @ w_out_b[o]
        x = x + y.astype(x.dtype)
        x = x + _sq_relu_mlp(_rms_norm(x, norm_mlp[layer]), w_ff1[layer], w_ff2[layer]).astype(x.dtype)
    return x
```

```cpp
#include <hip/hip_runtime.h>
#include <hip/hip_cooperative_groups.h>
#include <cstdio>
namespace cg = cooperative_groups;
#ifndef MK_PER_PHASE
#define MK_PER_PHASE 0
#endif
namespace pg8 {
#define PG8_LAS __attribute__((address_space(3)))
typedef unsigned short bf16_t;
typedef short bf16x8 __attribute__((ext_vector_type(8)));
typedef float f32x4 __attribute__((ext_vector_type(4)));
typedef unsigned u32x4 __attribute__((ext_vector_type(4)));
constexpr int BM = 256, BK = 64, HALF = 128, HTB = HALF * BK * 2  , STAGE_BYTES = 8 * HTB, NXCD = 8, WGM = 8;

__host__ __device__ __forceinline__ int lds_byte(int r, int c) { const int st = (r >> 4) * 2 + (c >> 5), rr = r & 15, cc = c & 31, ob = rr * 64 + cc * 2; return st * 1024 + (ob ^ (((ob >> 9) & 1) << 5)); }
__host__ __device__ __forceinline__ void stage_rc(int b, int& R, int& C) { const int st = b / 1024, sb = b % 1024, swz = sb ^ (((sb >> 9) & 1) << 5); R = (st >> 1) * 16 + swz / 64; C = (st & 1) * 32 + (swz % 64) / 2; }
__host__ __device__ __forceinline__ int perm32(int rho) { const int n = rho >> 4, i = rho & 15; return 8 * (i >> 2) + 4 * n + (i & 3); }

struct Unit { int pm, pn; };
struct Gemm { const bf16_t* A; const bf16_t* Bt; int M, N, K, lda, ldb; };

struct StaticOrder {
    int nM, nN, nwg, G, c;
    __host__ __device__ void init(int M, int N, int G_, int c_) { nM = M / BM; nN = N / BM; nwg = nM * nN; G = G_; c = c_; }
    __host__ __device__ bool next(int i, Unit& u) const {
        const long L = (long)i * G + c; if (L >= nwg) return false;
        int wgid = (int)L; { const int q = nwg / NXCD, r = nwg % NXCD, xcd = wgid % NXCD, off = wgid / NXCD; wgid = (xcd < r ? xcd * (q + 1) : r * (q + 1) + (xcd - r) * q) + off; }
        const int nig = WGM * nN, gid = wgid / nig, fm = gid * WGM, gsz = (nM - fm) < WGM ? (nM - fm) : WGM;
        u.pm = fm + ((wgid % nig) % gsz); u.pn = (wgid % nig) / gsz; return true;
    }
    __device__ __forceinline__ void a_ready(const Unit&) const {}
    __device__ __forceinline__ void done(const Unit&) const {}
};
__device__ __forceinline__ unsigned cvt_pk_bf16(float lo, float hi) { unsigned r; asm volatile("v_cvt_pk_bf16_f32 %0, %1, %2" : "=v"(r) : "v"(lo), "v"(hi)); return r; }
typedef float f32x2 __attribute__((ext_vector_type(2)));
template <class Epi, class Sched, bool STAMP = false>
__device__ __forceinline__ void gemm_phase(PG8_LAS unsigned char* lds, const Gemm g, const Sched& S, const Epi& E, unsigned long long* stamps) {
    const int tid = threadIdx.x, wid = __builtin_amdgcn_readfirstlane(tid >> 6), lane = tid & 63, wr = wid >> 2, wc = wid & 3, fr = lane & 15, fq = lane >> 4;
    const int K = g.K, nt = K / BK;
    int ts_lo = 0, ts_hi = 0, nts = 0; const unsigned long long rt_entry = STAMP ? (unsigned long long)wall_clock64() : 0ull;
#define PG8_STAMP() do { if (STAMP && wid == 0 && nts < 64) { const unsigned long long _c = (unsigned long long)clock64(); \
        ts_lo = (lane == nts) ? (int)(unsigned)_c : ts_lo; ts_hi = (lane == nts) ? (int)(unsigned)(_c >> 32) : ts_hi; ++nts; } } while (0)
    PG8_STAMP();
    unsigned voffA[2], voffB[2];
#pragma unroll
    for (int i = 0; i < 2; ++i) { int R, C; stage_rc(tid * 16 + i * 8192, R, C); const int Rb = Epi::PERM ? ((R & ~31) + perm32(R & 31)) : R;
        voffA[i] = (unsigned)(R * g.lda + C) * 2u; voffB[i] = (unsigned)(Rb * g.ldb + C) * 2u; }
    const size_t kstep = (size_t)(BK * 2);
    const size_t hstepA = (size_t)HALF * g.lda * 2, hstepB = (size_t)HALF * g.ldb * 2;
    const size_t tstepA = 2 * hstepA, tstepB = 2 * hstepB;
    const unsigned ldsw = (unsigned)wid * 1024u;
    const int aoff = lds_byte(wr * 64 + fr, fq * 8), boff = lds_byte(wc * 32 + fr, fq * 8);
#define PG8_SA(b, h) (((b) * 2 + (h)) * HTB)
#define PG8_SB(b, h) ((4 + (b) * 2 + (h)) * HTB)
#define PG8_STAGE(bufoff, gbase, voff) do { _Pragma("unroll") for (int _i = 0; _i < 2; ++_i) \
        __builtin_amdgcn_global_load_lds((const unsigned*)((const char*)(gbase) + (voff)[_i]), (PG8_LAS unsigned*)(lds + (bufoff) + ldsw + _i * 8192), 16, 0, 0); } while (0)
#define PG8_LDA(dst, b, h) do { _Pragma("unroll") for (int m = 0; m < 4; ++m) _Pragma("unroll") for (int k = 0; k < 2; ++k) dst[m][k] = *(const PG8_LAS bf16x8*)(lds + PG8_SA(b, h) + aoff + m * 2048 + k * 1024); } while (0)
#define PG8_LDB(dst, b, h) do { _Pragma("unroll") for (int n = 0; n < 2; ++n) _Pragma("unroll") for (int k = 0; k < 2; ++k) dst[n][k] = *(const PG8_LAS bf16x8*)(lds + PG8_SB(b, h) + boff + n * 2048 + k * 1024); } while (0)
#define PG8_MMA(ai, bj, At, Bt) do { __builtin_amdgcn_s_setprio(1); _Pragma("unroll") for (int m = 0; m < 4; ++m) _Pragma("unroll") for (int n = 0; n < 2; ++n) _Pragma("unroll") for (int k = 0; k < 2; ++k) \
        acc[ai][bj][m][n] = __builtin_amdgcn_mfma_f32_16x16x32_bf16(Bt[n][k], At[m][k], acc[ai][bj][m][n], 0, 0, 0); __builtin_amdgcn_s_setprio(0); } while (0)
#define PG8_WAIT_V(n) asm volatile("s_waitcnt vmcnt(" #n ")" ::: "memory")
#define PG8_WAIT_L(n) asm volatile("s_waitcnt lgkmcnt(" #n ")" ::: "memory")
#define PG8_BAR __builtin_amdgcn_s_barrier()
#define PG8_SCHED __builtin_amdgcn_sched_barrier(0)
    Unit cur, nxt; int ui = 0;
    if (!S.next(0, cur)) return;
    f32x4 acc[2][2][4][2];
#pragma unroll
    for (int a = 0; a < 2; ++a)
#pragma unroll
        for (int b = 0; b < 2; ++b)
#pragma unroll
            for (int m = 0; m < 4; ++m)
#pragma unroll
                for (int n = 0; n < 2; ++n) acc[a][b][m][n] = (f32x4){0.f, 0.f, 0.f, 0.f};
    bf16x8 At[4][2], B0[2][2], B1[2][2];
    const char* cA = (const char*)g.A + (size_t)cur.pm * tstepA; const char* cB = (const char*)g.Bt + (size_t)cur.pn * tstepB;
    S.a_ready(cur);
    PG8_STAGE(PG8_SB(0, 0), cB, voffB); PG8_STAGE(PG8_SA(0, 0), cA, voffA); PG8_STAGE(PG8_SB(0, 1), cB + hstepB, voffB); PG8_STAGE(PG8_SA(0, 1), cA + hstepA, voffA);
    if (wr == 1) PG8_BAR;
    PG8_WAIT_V(4); PG8_BAR;
    PG8_STAGE(PG8_SB(1, 0), cB + kstep, voffB); PG8_STAGE(PG8_SA(1, 0), cA + kstep, voffA); PG8_STAGE(PG8_SB(1, 1), cB + hstepB + kstep, voffB);
    PG8_WAIT_V(6); PG8_BAR;
    PG8_STAMP();
    for (;;) {
        const bool has_next = S.next(ui + 1, nxt);
        const char* nA = has_next ? (const char*)g.A + (size_t)nxt.pm * tstepA : cA; const char* nB = has_next ? (const char*)g.Bt + (size_t)nxt.pn * tstepB : cB;
        for (int t = 0; t < nt; t += 2) {
            const bool last = (t == nt - 2);
            const char* a1 = cA + (size_t)(t + 1) * kstep;
            const char* a2 = last ? nA : cA + (size_t)(t + 2) * kstep; const char* b2 = last ? nB : cB + (size_t)(t + 2) * kstep;
            const char* a3 = a2 + kstep; const char* b3 = b2 + kstep;
            if (last && has_next) S.a_ready(nxt);
            PG8_LDB(B0, 0, 0); PG8_SCHED; PG8_LDA(At, 0, 0); PG8_STAGE(PG8_SA(1, 1), a1 + hstepA, voffA);
            PG8_WAIT_L(8); PG8_BAR; PG8_WAIT_L(0); PG8_MMA(0, 0, At, B0); PG8_BAR; PG8_SCHED;
            PG8_LDB(B1, 0, 1); PG8_STAGE(PG8_SB(0, 0), b2, voffB);
            PG8_BAR; PG8_WAIT_L(0); PG8_MMA(0, 1, At, B1); PG8_BAR;
            PG8_LDA(At, 0, 1); PG8_STAGE(PG8_SA(0, 0), a2, voffA);
            PG8_BAR; PG8_WAIT_L(0); PG8_MMA(1, 0, At, B0); PG8_BAR; PG8_SCHED;
            PG8_STAGE(PG8_SB(0, 1), b2 + hstepB, voffB);
            PG8_WAIT_V(6); PG8_BAR; PG8_MMA(1, 1, At, B1); PG8_BAR;
            PG8_LDB(B0, 1, 0); PG8_SCHED; PG8_LDA(At, 1, 0); PG8_STAGE(PG8_SA(0, 1), a2 + hstepA, voffA);
            PG8_WAIT_L(8); PG8_BAR; PG8_WAIT_L(0); PG8_MMA(0, 0, At, B0); PG8_BAR; PG8_SCHED;
            PG8_LDB(B1, 1, 1); PG8_STAGE(PG8_SB(1, 0), b3, voffB);
            PG8_BAR; PG8_WAIT_L(0); PG8_MMA(0, 1, At, B1); PG8_BAR;
            PG8_LDA(At, 1, 1); PG8_STAGE(PG8_SA(1, 0), a3, voffA);
            PG8_BAR; PG8_WAIT_L(0); PG8_MMA(1, 0, At, B0); PG8_BAR; PG8_SCHED;
            PG8_STAGE(PG8_SB(1, 1), b3 + hstepB, voffB);
            PG8_WAIT_V(6); PG8_BAR; PG8_MMA(1, 1, At, B1); PG8_BAR;
        }
        PG8_STAMP();
        if constexpr (!Epi::AFTER_DRAIN) { E(acc, cur, wr, wc, fr, fq); S.done(cur); }
        PG8_STAMP();
        if (!has_next) break;
#pragma unroll
        for (int a = 0; a < 2; ++a)
#pragma unroll
            for (int b = 0; b < 2; ++b)
#pragma unroll
                for (int m = 0; m < 4; ++m)
#pragma unroll
                    for (int n = 0; n < 2; ++n) acc[a][b][m][n] = (f32x4){0.f, 0.f, 0.f, 0.f};
        cur = nxt; cA = nA; cB = nB; ++ui;
    }
    PG8_WAIT_V(0);
    if (wr == 0) PG8_BAR;
    PG8_BAR;
    if constexpr (Epi::AFTER_DRAIN) { E.fused(acc, cur, wr, wc, fr, fq, lds, wid, lane); S.done(cur); }
    PG8_STAMP();
    if (STAMP && wid == 0) { stamps[lane] = lane < nts ? (((unsigned long long)(unsigned)ts_hi << 32) | (unsigned)ts_lo) : 0ull;
        if (lane == 62) stamps[62] = rt_entry; if (lane == 63) stamps[63] = (unsigned long long)wall_clock64(); }
#undef PG8_STAMP
#undef PG8_SA
#undef PG8_SB
#undef PG8_STAGE
#undef PG8_LDA
#undef PG8_LDB
#undef PG8_MMA
#undef PG8_WAIT_V
#undef PG8_WAIT_L
#undef PG8_BAR
#undef PG8_SCHED
}
}
using pg8::bf16_t; using pg8::bf16x8; using pg8::f32x4; using pg8::u32x4; using pg8::cvt_pk_bf16;
typedef unsigned u32x2 __attribute__((ext_vector_type(2)));
#define LAS __attribute__((address_space(3)))
constexpr int S = 16384, DM = 2048, FF = 8192, UC = 6144;
constexpr size_t MiB = (size_t)1 << 20;
constexpr size_t WS_WIN = 0, WS_WOUT = 24 * MiB, WS_W1 = 32 * MiB, WS_W2 = 64 * MiB, WS_CMPW = 96 * MiB, WS_LORA = 98 * MiB, WS_LRUG = 96 * MiB, WS_SMALL = 101 * MiB;
constexpr size_t WS_HB = 102 * MiB, WS_X2 = 166 * MiB, WS_U = 294 * MiB, WS_D2 = 486 * MiB, WS_END = 512 * MiB;
constexpr size_t WS_QB = 166 * MiB, WS_KSB = 198 * MiB, WS_KWB = 206 * MiB, WS_KCVC = 214 * MiB, WS_VST = 230 * MiB, WS_VWT = 238 * MiB, WS_YB = 246 * MiB;
constexpr size_t WS_ALORA = 486 * MiB, WS_CMPC = 502 * MiB, WS_GT = 506 * MiB, WS_KCB = 508 * MiB, WS_VCT = 508 * MiB + 512 * 1024;
constexpr size_t WS_LRUP = 486 * MiB, WS_LRUH = 487 * MiB, WS_HGD = 488 * MiB;
constexpr size_t WS_Z = 294 * MiB;
constexpr size_t DO_RWX = 0;
constexpr size_t DO_RG = 0, DO_HGS = 64 * MiB;
constexpr int LDS_BYTES = 144 * 1024;
constexpr int NPHASE = 26;

struct Params { const float* in[32]; float* out; unsigned char* ws; int ph_lo, ph_hi; };

__device__ __forceinline__ float bf2f(bf16_t b) { return __uint_as_float(((unsigned)b) << 16); }
__device__ __forceinline__ bf16_t f2bf(float f) { unsigned u = __float_as_uint(f); u += 0x7FFFu + ((u >> 16) & 1u); return (bf16_t)(u >> 16); }
__device__ __forceinline__ float wave_sum(float v) {
#pragma unroll
    for (int o = 1; o < 64; o <<= 1) v += __shfl_xor(v, o);
    return v;
}
__device__ __forceinline__ float sigm(float x) { return 1.0f / (1.0f + expf(-x)); }
__device__ __forceinline__ float softplusf(float x) { return x > 20.f ? x : log1pf(expf(x)); }
__device__ __forceinline__ float row16_sum(float v) {
    v += __int_as_float(__builtin_amdgcn_update_dpp(0, __float_as_int(v), 0xB1, 0xF, 0xF, true));
    v += __int_as_float(__builtin_amdgcn_update_dpp(0, __float_as_int(v), 0x4E, 0xF, 0xF, true));
    v += __int_as_float(__builtin_amdgcn_update_dpp(0, __float_as_int(v), 0x141, 0xF, 0xF, true));
    v += __int_as_float(__builtin_amdgcn_update_dpp(0, __float_as_int(v), 0x140, 0xF, 0xF, true));
    return v;
}
#define MFMA16(a, b, c) __builtin_amdgcn_mfma_f32_16x16x32_bf16((a), (b), (c), 0, 0, 0)

struct EpiF32 {
    static constexpr bool PERM = false, AFTER_DRAIN = false;
    float* C; int ldc;
    __device__ __forceinline__ void operator()(const f32x4 (&acc)[2][2][4][2], const pg8::Unit& u, int wr, int wc, int fr, int fq) const {
        const int row0 = u.pm * 256 + wr * 64 + fr, col0 = u.pn * 256 + wc * 32 + 4 * fq;
#pragma unroll
        for (int ai = 0; ai < 2; ++ai)
#pragma unroll
            for (int m = 0; m < 4; ++m) { float* rowp = C + (size_t)(row0 + ai * 128 + m * 16) * ldc + col0;
#pragma unroll
                for (int bj = 0; bj < 2; ++bj)
#pragma unroll
                    for (int n = 0; n < 2; ++n) *(f32x4*)(rowp + bj * 128 + n * 16) = acc[ai][bj][m][n]; }
    }
};
struct EpiResid {
    static constexpr bool PERM = false, AFTER_DRAIN = false;
    const float* base; float* out;
    __device__ __forceinline__ void operator()(const f32x4 (&acc)[2][2][4][2], const pg8::Unit& u, int wr, int wc, int fr, int fq) const {
        const int row0 = u.pm * 256 + wr * 64 + fr, col0 = u.pn * 256 + wc * 32 + 4 * fq;
#pragma unroll
        for (int ai = 0; ai < 2; ++ai)
#pragma unroll
            for (int m = 0; m < 4; ++m) { const size_t off = (size_t)(row0 + ai * 128 + m * 16) * DM + col0;
#pragma unroll
                for (int bj = 0; bj < 2; ++bj)
#pragma unroll
                    for (int n = 0; n < 2; ++n) { const f32x4 b = *(const f32x4*)(base + off + bj * 128 + n * 16); *(f32x4*)(out + off + bj * 128 + n * 16) = b + acc[ai][bj][m][n]; }
                asm volatile("" ::: "memory"); }
    }
};
template <int ACT  > struct EpiBf16 {
    static constexpr bool PERM = true, AFTER_DRAIN = false;
    bf16_t* O; int ldc;
    __device__ __forceinline__ void operator()(const f32x4 (&acc)[2][2][4][2], const pg8::Unit& u, int wr, int wc, int fr, int fq) const {
        const int row0 = u.pm * 256 + wr * 64 + fr, col0 = u.pn * 256 + wc * 32 + 8 * fq;
#pragma unroll
        for (int ai = 0; ai < 2; ++ai)
#pragma unroll
            for (int m = 0; m < 4; ++m) { bf16_t* rowp = O + (size_t)(row0 + ai * 128 + m * 16) * ldc + col0;
#pragma unroll
                for (int bj = 0; bj < 2; ++bj) { f32x4 v0 = acc[ai][bj][m][0], v1 = acc[ai][bj][m][1];
                    if (ACT == 1) {
#pragma unroll
                        for (int j = 0; j < 4; ++j) { float a = fmaxf(v0[j], 0.f), b = fmaxf(v1[j], 0.f); v0[j] = a * a; v1[j] = b * b; } }
                    u32x4 w; w.x = cvt_pk_bf16(v0[0], v0[1]); w.y = cvt_pk_bf16(v0[2], v0[3]); w.z = cvt_pk_bf16(v1[0], v1[1]); w.w = cvt_pk_bf16(v1[2], v1[3]);
                    *(u32x4*)(rowp + bj * 128) = w; } }
    }
};
template <class Epi> __device__ __forceinline__ void run_gemm(LAS unsigned char* lds, const bf16_t* A, int lda, const bf16_t* Bt, int ldb, int M, int N, int K, const Epi& E) {
    pg8::Gemm g; g.A = A; g.Bt = Bt; g.M = M; g.N = N; g.K = K; g.lda = lda; g.ldb = ldb;
    pg8::StaticOrder so; so.init(M, N, (int)gridDim.x, (int)blockIdx.x);
    __syncthreads();
    pg8::gemm_phase<Epi, pg8::StaticOrder, false>(lds, g, so, E, nullptr);
    __syncthreads();
}

template <typename SrcT> __device__ __forceinline__ void tconv(const SrcT* src, size_t ld, int K, int N, int Npad, bf16_t* dst, size_t dld, const float* bias, int zero_k, LAS float* tile) {
    const int tid = threadIdx.x, nN = Npad / 64, ntiles = (K / 64) * nN;
    for (int id = blockIdx.x; id < ntiles; id += gridDim.x) {
        const int k0 = (id / nN) * 64, n0 = (id % nN) * 64;
        const int r = tid >> 4, c4 = tid & 15, n = n0 + 4 * c4;
#pragma unroll
        for (int h = 0; h < 2; ++h) { const int rr = r + 32 * h, k = k0 + rr; float v[4] = {0.f, 0.f, 0.f, 0.f};
            if (n < N && k != zero_k) {
                if constexpr (sizeof(SrcT) == 4) { const f32x4 x = *(const f32x4*)((const float*)src + (size_t)k * ld + n); v[0] = x[0]; v[1] = x[1]; v[2] = x[2]; v[3] = x[3]; }
                else { const u32x2 x = *(const u32x2*)((const bf16_t*)src + (size_t)k * ld + n); v[0] = bf2f((bf16_t)(x.x & 0xffff)); v[1] = bf2f((bf16_t)(x.x >> 16)); v[2] = bf2f((bf16_t)(x.y & 0xffff)); v[3] = bf2f((bf16_t)(x.y >> 16)); }
                if (bias) { v[0] += bias[n]; v[1] += bias[n + 1]; v[2] += bias[n + 2]; v[3] += bias[n + 3]; } }
#pragma unroll
            for (int j = 0; j < 4; ++j) tile[rr * 65 + 4 * c4 + j] = v[j]; }
        __syncthreads();
        const int nn = tid >> 3, kc = tid & 7; const LAS float* s = tile + (8 * kc) * 65 + nn;
        u32x4 o; o.x = cvt_pk_bf16(s[0], s[65]); o.y = cvt_pk_bf16(s[2 * 65], s[3 * 65]); o.z = cvt_pk_bf16(s[4 * 65], s[5 * 65]); o.w = cvt_pk_bf16(s[6 * 65], s[7 * 65]);
        *(u32x4*)(dst + (size_t)(n0 + nn) * dld + k0 + 8 * kc) = o;
        __syncthreads();
    }
}
__device__ __forceinline__ void rmsnorm_rows(const float* X, const float* g, bf16_t* out, int rows) {
    const int lane = threadIdx.x & 63, gw = blockIdx.x * 8 + (threadIdx.x >> 6), NGW = gridDim.x * 8;
    for (int row = gw; row < rows; row += NGW) {
        const f32x4* xr = (const f32x4*)(X + (size_t)row * DM) + lane; f32x4 v[8]; float s = 0.f;
#pragma unroll
        for (int j = 0; j < 8; ++j) { v[j] = xr[64 * j]; s += (v[j][0] * v[j][0] + v[j][1] * v[j][1]) + (v[j][2] * v[j][2] + v[j][3] * v[j][3]); }
        const float rinv = rsqrtf(wave_sum(s) * (1.0f / DM) + 1e-6f);
#pragma unroll
        for (int j = 0; j < 8; ++j) { const f32x4 gv = ((const f32x4*)g)[lane + 64 * j]; u32x2 o; o.x = cvt_pk_bf16(v[j][0] * rinv * gv[0], v[j][1] * rinv * gv[1]); o.y = cvt_pk_bf16(v[j][2] * rinv * gv[2], v[j][3] * rinv * gv[3]);
            *(u32x2*)(out + (size_t)row * DM + 4 * (lane + 64 * j)) = o; }
    }
}
__device__ __forceinline__ void phase_prep0(const Params& p, LAS unsigned char* lds) {
    unsigned char* ws = p.ws; LAS float* tile = (LAS float*)lds; const int tid = threadIdx.x;
    if (blockIdx.x == gridDim.x - 1) {
        float* sm = (float*)(ws + WS_SMALL);
        if (tid < 256) { const int w = tid >> 7, e = tid & 127; const float* pe = p.in[9] + w * 4096; const float* cw = p.in[8] + (size_t)w * 4096 * 128 + e; float s = 0.f;
#pragma unroll 8
            for (int i = 0; i < 4096; ++i) s += pe[i] * cw[(size_t)i * 128];
            sm[tid] = s; }
        if (tid == 256) { const float* g = p.in[7]; float mx[4];
            for (int a = 0; a < 4; ++a) { float m = 0.f; for (int i = 0; i < 128; ++i) m = fmaxf(m, fabsf(g[a * 128 + i])); mx[a] = m; }
            for (int a = 0; a < 3; ++a) sm[256 + a] = 11.3137085f * mx[0] * mx[1 + a] * 1.0002f + 0.01f; }
        if (tid == 257) { unsigned* ctl = (unsigned*)(ws + WS_SMALL + 2048); ctl[0] = 0u; }
    }
    tconv<float>(p.in[5], 6104, 2048, 6104, 6144, (bf16_t*)(ws + WS_WIN), 2048, nullptr, -1, tile);
    tconv<float>(p.in[6], 2048, 2048, 2048, 2048, (bf16_t*)(ws + WS_WOUT), 2048, nullptr, -1, tile);
    tconv<float>(p.in[3], 8192, 2048, 8192, 8192, (bf16_t*)(ws + WS_W1), 2048, nullptr, -1, tile);
    tconv<float>(p.in[4], 2048, 8192, 2048, 2048, (bf16_t*)(ws + WS_W2), 8192, nullptr, -1, tile);
    tconv<float>(p.in[8], 128, 4096, 128, 128, (bf16_t*)(ws + WS_CMPW), 4096, nullptr, -1, tile);
    tconv<float>(p.in[8] + (size_t)4096 * 128, 128, 4096, 128, 128, (bf16_t*)(ws + WS_CMPW) + (size_t)128 * 4096, 4096, nullptr, -1, tile);
    { bf16_t* LT = (bf16_t*)(ws + WS_LORA); const float *w2 = p.in[12], *a2 = p.in[14], *g2 = p.in[15];
      for (int idx = blockIdx.x * 512 + tid; idx < 3072 * 512; idx += gridDim.x * 512) { const int n = idx >> 9, k = idx & 511; float v = 0.f;
          if (n < 1024) { if (k < 96) v = w2[k * 1024 + n]; }
          else if (n < 2048) { if (k >= 128 && k < 224) v = a2[(k - 128) * 1024 + n - 1024]; }
          else { if (k >= 256) v = g2[(k - 256) * 1024 + n - 2048]; }
          LT[idx] = f2bf(v); } }
    rmsnorm_rows(p.in[0], p.in[1], (bf16_t*)(ws + WS_HB), S);
}
__device__ __forceinline__ void phase_prep1(const Params& p, LAS unsigned char* lds) {
    unsigned char* ws = p.ws; LAS float* tile = (LAS float*)lds; const int tid = threadIdx.x;
    tconv<float>(p.in[21], 6144, 2048, 6144, 6144, (bf16_t*)(ws + WS_WIN), 2048, nullptr, -1, tile);
    tconv<float>(p.in[22], 2048, 2048, 2048, 2048, (bf16_t*)(ws + WS_WOUT), 2048, nullptr, -1, tile);
    tconv<float>(p.in[3] + (size_t)2048 * 8192, 8192, 2048, 8192, 8192, (bf16_t*)(ws + WS_W1), 2048, nullptr, -1, tile);
    tconv<float>(p.in[4] + (size_t)2048 * 8192, 2048, 8192, 2048, 2048, (bf16_t*)(ws + WS_W2), 8192, nullptr, -1, tile);
    { bf16_t* GT_ = (bf16_t*)(ws + WS_LRUG); const float *wa = p.in[25], *wx = p.in[27];
      for (int idx = blockIdx.x * 512 + tid; idx < 2048 * 1024; idx += gridDim.x * 512) { const int n = idx >> 10, k = idx & 1023, ch = n >> 1, blk = ch >> 7, d = ch & 127; float v = 0.f;
          if ((k >> 7) == blk) v = ((n & 1) ? wx : wa)[(blk * 128 + (k & 127)) * 128 + d];
          GT_[idx] = f2bf(v); } }
    rmsnorm_rows((const float*)(ws + WS_X2), p.in[1] + DM, (bf16_t*)(ws + WS_HB), S);
}

__device__ __forceinline__ void norm_rope_store(const bf16_t* src, bf16_t* dst, float ga, float gb, float cs, float sn, int lane) {
    const float x1 = bf2f(src[lane]), x2 = bf2f(src[64 + lane]);
    const float rinv = rsqrtf(wave_sum(x1 * x1 + x2 * x2) * (1.0f / 128.f) + 1e-6f);
    const float y1 = x1 * rinv * ga, y2 = x2 * rinv * gb;
    dst[lane] = f2bf(y1 * cs - y2 * sn); dst[64 + lane] = f2bf(y1 * sn + y2 * cs);
}
__device__ __forceinline__ void phase_tok0(const Params& p, LAS unsigned char* lds) {
    unsigned char* ws = p.ws; const int lane = threadIdx.x & 63, gw = blockIdx.x * 8 + (threadIdx.x >> 6), NGW = gridDim.x * 8;
    const bf16_t* U = (const bf16_t*)(ws + WS_U);
    bf16_t *QB = (bf16_t*)(ws + WS_QB), *KSB = (bf16_t*)(ws + WS_KSB), *KWB = (bf16_t*)(ws + WS_KWB), *KCVC = (bf16_t*)(ws + WS_KCVC), *AL = (bf16_t*)(ws + WS_ALORA);
    float* GT = (float*)(ws + WS_GT);
    const float* gain = p.in[7]; const float* mu = p.in[10];
    const float g0a = gain[lane], g0b = gain[64 + lane], g2a = gain[256 + lane], g2b = gain[320 + lane], g3a = gain[384 + lane], g3b = gain[448 + lane];
    const float invf = powf(10000.0f, -((float)(2 * lane) / 128.0f));
    for (int t = gw; t < S; t += NGW) {
        const bf16_t* u = U + (size_t)t * UC;
        float sn, cs; sincosf((float)t * invf, &sn, &cs);
        for (int hh = 0; hh < 8; ++hh) norm_rope_store(u + hh * 128, QB + ((size_t)t * 8 + hh) * 128, g0a, g0b, cs, sn, lane);
        for (int g = 0; g < 2; ++g) {
            bf16_t* kc = KCVC + ((size_t)g * S + t) * 128; bf16_t* vc = KCVC + ((size_t)(2 + g) * S + t) * 128;
            kc[lane] = u[1024 + g * 128 + lane]; kc[64 + lane] = u[1024 + g * 128 + 64 + lane];
            vc[lane] = u[1280 + g * 128 + lane]; vc[64 + lane] = u[1280 + g * 128 + 64 + lane];
            norm_rope_store(u + 1536 + g * 128, KSB + ((size_t)g * S + t) * 128, g2a, g2b, cs, sn, lane);
            norm_rope_store(u + 2048 + g * 128, KWB + ((size_t)g * S + t) * 128, g3a, g3b, cs, sn, lane);
        }
        if (lane < 24) GT[(size_t)t * 24 + lane] = sigm(bf2f(u[2560 + lane]));
        bf16_t* al = AL + (size_t)t * 512;
#pragma unroll
        for (int i = 0; i < 7; ++i) { const int c = 3072 + lane + 64 * i, col = 2584 + c; const float cur = bf2f(u[col]), prev = t > 0 ? bf2f(u[col - UC]) : 0.f; const float xm = cur + (prev - cur) * mu[c];
            if (c < 3168) al[c - 3072] = f2bf(tanhf(xm)); else if (c < 3264) al[128 + c - 3168] = f2bf(xm); else al[256 + c - 3264] = f2bf(sigm(xm)); }
        if (lane < 32) { al[96 + lane] = 0; al[224 + lane] = 0; }
    }
    LAS float* tile = (LAS float*)lds;
    tconv<bf16_t>(U + 1792, UC, S, 256, 256, (bf16_t*)(ws + WS_VST), S, nullptr, -1, tile);
    tconv<bf16_t>(U + 2304, UC, S, 256, 256, (bf16_t*)(ws + WS_VWT), S, nullptr, -1, tile);
}
__device__ __forceinline__ void phase_cmpfin(const Params& p, LAS unsigned char* lds) {
    unsigned char* ws = p.ws; const int lane = threadIdx.x & 63, gw = blockIdx.x * 8 + (threadIdx.x >> 6), NGW = gridDim.x * 8;
    const float* C = (const float*)(ws + WS_CMPC); const float* cb = (const float*)(ws + WS_SMALL); bf16_t* KCB = (bf16_t*)(ws + WS_KCB);
    const float* gain = p.in[7]; const float g1a = gain[128 + lane], g1b = gain[192 + lane];
    const float invf = powf(10000.0f, -((float)(2 * lane) / 128.0f));
    for (int row = gw; row < 2048; row += NGW) { const int n = row & 1023; bf16_t* dst = KCB + (size_t)row * 128;
        if (n == 1023) { dst[lane] = 0; dst[64 + lane] = 0; continue; }
        const float x1 = C[(size_t)row * 256 + lane] + cb[lane], x2 = C[(size_t)row * 256 + 64 + lane] + cb[64 + lane];
        const float rinv = rsqrtf(wave_sum(x1 * x1 + x2 * x2) * (1.0f / 128.f) + 1e-6f);
        const float y1 = x1 * rinv * g1a, y2 = x2 * rinv * g1b; float sn, cs; sincosf((float)(16 * n + 31) * invf, &sn, &cs);
        dst[lane] = f2bf(y1 * cs - y2 * sn); dst[64 + lane] = f2bf(y1 * sn + y2 * cs); }
    { bf16_t* RWX = (bf16_t*)((unsigned char*)p.out + DO_RWX); const float *w0 = p.in[11], *a0 = p.in[13];
      for (int idx = blockIdx.x * 512 + threadIdx.x; idx < S * 512; idx += gridDim.x * 512) { const int t = idx >> 9, c = (idx & 511) * 4; u32x2* pp = (u32x2*)(RWX + (size_t)t * 3072 + c); const u32x2 x = *pp; float v[4];
          v[0] = bf2f((bf16_t)(x.x & 0xffff)); v[1] = bf2f((bf16_t)(x.x >> 16)); v[2] = bf2f((bf16_t)(x.y & 0xffff)); v[3] = bf2f((bf16_t)(x.y >> 16));
          if (c < 1024) {
#pragma unroll
              for (int i = 0; i < 4; ++i) { const float w = -softplusf(-(w0[c + i] + v[i])) - 0.5f; v[i] = -expf(w); } }
          else {
#pragma unroll
              for (int i = 0; i < 4; ++i) v[i] = sigm(a0[c - 1024 + i] + v[i]); }
          u32x2 o; o.x = cvt_pk_bf16(v[0], v[1]); o.y = cvt_pk_bf16(v[2], v[3]); *pp = o; } }
    LAS float* tile = (LAS float*)lds;
    for (int g = 0; g < 2; ++g)
        tconv<float>(C + (size_t)(2048 + g * 1024) * 256 + 128, 256, 1024, 128, 128, (bf16_t*)(ws + WS_VCT) + (size_t)g * 128 * 1024, 1024, cb + 128, 1023, tile);
}
constexpr int NS_KT = 0, NS_VT = 17408, NS_IMP = 35840, NS_SEL = 69120, NS_UNI = 70144, NS_ITEM = 70176;
__device__ __forceinline__ void ns_stage(LAS unsigned char* lds, const bf16_t* Ksrc, const bf16_t* VTsrc, size_t vld, bool withV) {
    const int tid = threadIdx.x;
#pragma unroll
    for (int i = 0; i < 2; ++i) { const int id = tid + 512 * i, row = id >> 4, ch = id & 15; const u32x4 v = *(const u32x4*)(Ksrc + (size_t)row * 128 + ch * 8); *(LAS u32x4*)(lds + NS_KT + row * 272 + ch * 16) = v; }
    if (withV) {
#pragma unroll
        for (int i = 0; i < 2; ++i) { const int id = tid + 512 * i, d = id >> 3, ch = id & 7; const u32x4 v = *(const u32x4*)(VTsrc + (size_t)d * vld + ch * 8); *(LAS u32x4*)(lds + NS_VT + d * 144 + ch * 16) = v; } }
}
__device__ __forceinline__ void ns_qk(LAS unsigned char* lds, int grp, const bf16x8 (&qf)[4], int lane, f32x4& s0, f32x4& s1) {
    const int i = lane & 15, quad = lane >> 4, krow = 32 * grp + (i >> 2) * 8 + (i & 3);
    s0 = (f32x4){0.f, 0.f, 0.f, 0.f}; s1 = s0;
#pragma unroll
    for (int ks = 0; ks < 4; ++ks) {
        const bf16x8 a0 = *(const LAS bf16x8*)(lds + NS_KT + krow * 272 + (32 * ks + 8 * quad) * 2);
        const bf16x8 a1 = *(const LAS bf16x8*)(lds + NS_KT + (krow + 4) * 272 + (32 * ks + 8 * quad) * 2);
        s0 = MFMA16(a0, qf[ks], s0); s1 = MFMA16(a1, qf[ks], s1); }
}
__device__ __forceinline__ void ns_pv(LAS unsigned char* lds, int grp, const f32x4& p0, const f32x4& p1, int lane, f32x4 (&o)[8]) {
    const int i = lane & 15, quad = lane >> 4;
    union { bf16x8 v; unsigned w[4]; } pf; pf.w[0] = cvt_pk_bf16(p0[0], p0[1]); pf.w[1] = cvt_pk_bf16(p0[2], p0[3]); pf.w[2] = cvt_pk_bf16(p1[0], p1[1]); pf.w[3] = cvt_pk_bf16(p1[2], p1[3]);
#pragma unroll
    for (int dt = 0; dt < 8; ++dt) { const bf16x8 a = *(const LAS bf16x8*)(lds + NS_VT + (16 * dt + i) * 144 + (32 * grp + 8 * quad) * 2); o[dt] = MFMA16(a, pf.v, o[dt]); }
}
__device__ __forceinline__ void nsa_item(const Params& p, LAS unsigned char* lds, int item) {
    unsigned char* ws = p.ws; const int tid = threadIdx.x, lane = tid & 63, w = tid >> 6, c = lane & 15, quad = lane >> 4, tq = c >> 2, j = c & 3;
    const int tile = 511 - (item >> 1), g = item & 1, t0 = tile * 32, t = t0 + 4 * w + tq;
    const bf16_t *QB = (const bf16_t*)(ws + WS_QB), *KSB = (const bf16_t*)(ws + WS_KSB), *KWB = (const bf16_t*)(ws + WS_KWB), *KCB = (const bf16_t*)(ws + WS_KCB);
    const bf16_t *VST = (const bf16_t*)(ws + WS_VST), *VWT = (const bf16_t*)(ws + WS_VWT), *VCT = (const bf16_t*)(ws + WS_VCT);
    const float* GT = (const float*)(ws + WS_GT); const float* sm = (const float*)(ws + WS_SMALL);
    const float sc2 = 0.08838834764831845f * 1.4426950408889634f;
    LAS float* imp = (LAS float*)(lds + NS_IMP) + w * 1040; LAS unsigned* sel = (LAS unsigned*)(lds + NS_SEL) + w * 32; LAS unsigned* uni = (LAS unsigned*)(lds + NS_UNI);
    bf16x8 qf[4];
#pragma unroll
    for (int ks = 0; ks < 4; ++ks) qf[ks] = *(const bf16x8*)(QB + ((size_t)t * 8 + 4 * g + j) * 128 + 32 * ks + 8 * quad);
    f32x4 otot[8], ob[8];
#pragma unroll
    for (int dt = 0; dt < 8; ++dt) { otot[dt] = (f32x4){0.f, 0.f, 0.f, 0.f}; ob[dt] = otot[dt]; }
    for (int i = lane; i < 1040; i += 64) imp[i] = 0.f;
    if (tid < 8) uni[tid] = 0u;
    {
        const float cb2 = sm[256] * 1.4426950408889634f; const int ncb = (t0 >> 4) / 64 + 1; float l = 0.f, linv = 0.f;
        for (int pass = 0; pass < 2; ++pass) {
            for (int blk = 0; blk < ncb; ++blk) {
                __syncthreads();
                ns_stage(lds, KCB + ((size_t)g * 1024 + 64 * blk) * 128, VCT + (size_t)g * 128 * 1024 + 64 * blk, 1024, pass == 1);
                __syncthreads();
#pragma unroll 1
                for (int grp = 0; grp < 2; ++grp) {
                    f32x4 s0, s1; ns_qk(lds, grp, qf, lane, s0, s1);
                    const int nb = 64 * blk + 32 * grp + 8 * quad;
#pragma unroll
                    for (int r = 0; r < 4; ++r) { s0[r] = (16 * (nb + r) + 31 <= t) ? __builtin_amdgcn_exp2f(s0[r] * sc2 - cb2) : 0.f; s1[r] = (16 * (nb + 4 + r) + 31 <= t) ? __builtin_amdgcn_exp2f(s1[r] * sc2 - cb2) : 0.f; }
                    if (pass == 0) { l += (s0[0] + s0[1]) + (s0[2] + s0[3]) + (s1[0] + s1[1]) + (s1[2] + s1[3]); }
                    else {
                        s0 *= linv; s1 *= linv;
                        float m0 = s0[0] + s0[1] + s0[2] + 0.5f * s0[3], n0 = 0.5f * s0[3], m1 = s1[0] + s1[1] + s1[2] + 0.5f * s1[3], n1 = 0.5f * s1[3];
                        m0 += __shfl_xor(m0, 1); m0 += __shfl_xor(m0, 2); n0 += __shfl_xor(n0, 1); n0 += __shfl_xor(n0, 2);
                        m1 += __shfl_xor(m1, 1); m1 += __shfl_xor(m1, 2); n1 += __shfl_xor(n1, 1); n1 += __shfl_xor(n1, 2);
                        if (j == 0) { const int m = nb >> 2; LAS float* ip = imp + tq * 260 + m; atomicAdd((float*)ip, m0); atomicAdd((float*)(ip + 1), n0 + m1); atomicAdd((float*)(ip + 2), n1); }
                        ns_pv(lds, grp, s0, s1, lane, ob);
                    }
                }
            }
            if (pass == 0) { l += __shfl_xor(l, 16); l += __shfl_xor(l, 32); linv = l > 0.f ? 1.0f / l : 0.f; }
        }
        const float gc = GT[(size_t)t * 24 + 4 * g + j];
#pragma unroll
        for (int dt = 0; dt < 8; ++dt) { otot[dt] += ob[dt] * gc; ob[dt] = (f32x4){0.f, 0.f, 0.f, 0.f}; }
    }
    __syncthreads();
    {
        const int R = lane >> 4, li = lane & 15, cur = (t0 + 4 * w + R) >> 6; LAS unsigned* selw = sel + R * 8;
        if (li < 8) selw[li] = 0u;
        if (cur < 16) { if (li == 0) selw[0] = (2u << cur) - 1u; }
        else {
            unsigned key[16];
#pragma unroll
            for (int i = 0; i < 16; ++i) { const int m = li + 16 * i; const float v = imp[R * 260 + m]; key[i] = (m >= 1 && m <= cur - 2) ? ((__float_as_uint(v) & 0xFFFFFF00u) | (unsigned)(255 - m)) : 0u; }
            for (int round = 0; round < 13; ++round) {
                unsigned bk = key[0];
#pragma unroll
                for (int i = 1; i < 16; ++i) bk = bk > key[i] ? bk : key[i];
#pragma unroll
                for (int o = 1; o < 16; o <<= 1) { const unsigned ok = (unsigned)__shfl_xor((int)bk, o); bk = bk > ok ? bk : ok; }
#pragma unroll
                for (int i = 0; i < 16; ++i) key[i] = key[i] == bk ? 0u : key[i];
                const int ms = 255 - (int)(bk & 255u);
                if (li == 0) selw[ms >> 5] |= 1u << (ms & 31);
            }
            if (li == 0) { selw[0] |= 1u; selw[cur >> 5] |= 1u << (cur & 31); selw[(cur - 1) >> 5] |= 1u << ((cur - 1) & 31); }
        }
    }
    __syncthreads();
    if (lane < 32) atomicOr((unsigned*)(uni + (lane & 7)), sel[lane]);
    __syncthreads();
    {
        const float cb2 = sm[257] * 1.4426950408889634f; const int ncur = (t0 + 31) >> 6; float l = 0.f;
        for (int m = 0; m <= ncur; ++m) {
            if (!((uni[m >> 5] >> (m & 31)) & 1u)) continue;
            __syncthreads();
            ns_stage(lds, KSB + ((size_t)g * S + 64 * m) * 128, VST + (size_t)g * 128 * S + 64 * m, S, true);
            __syncthreads();
            const bool mybit = (sel[tq * 8 + (m >> 5)] >> (m & 31)) & 1u;
            if (!__any(mybit)) continue;
#pragma unroll 1
            for (int grp = 0; grp < 2; ++grp) {
                f32x4 s0, s1; ns_qk(lds, grp, qf, lane, s0, s1);
                const int kb = 64 * m + 32 * grp + 8 * quad;
#pragma unroll
                for (int r = 0; r < 4; ++r) { s0[r] = (mybit && kb + r <= t) ? __builtin_amdgcn_exp2f(s0[r] * sc2 - cb2) : 0.f; s1[r] = (mybit && kb + 4 + r <= t) ? __builtin_amdgcn_exp2f(s1[r] * sc2 - cb2) : 0.f; }
                l += (s0[0] + s0[1]) + (s0[2] + s0[3]) + (s1[0] + s1[1]) + (s1[2] + s1[3]);
                ns_pv(lds, grp, s0, s1, lane, ob);
            }
        }
        l += __shfl_xor(l, 16); l += __shfl_xor(l, 32);
        const float gs = GT[(size_t)t * 24 + 8 + 4 * g + j] / l;
#pragma unroll
        for (int dt = 0; dt < 8; ++dt) { otot[dt] += ob[dt] * gs; ob[dt] = (f32x4){0.f, 0.f, 0.f, 0.f}; }
    }
    {
        const float cb2 = sm[258] * 1.4426950408889634f; const int mb0 = (t0 >= 511 ? (t0 - 511) : 0) >> 6, mb1 = t0 >> 6; float l = 0.f;
        for (int m = mb0; m <= mb1; ++m) {
            __syncthreads();
            ns_stage(lds, KWB + ((size_t)g * S + 64 * m) * 128, VWT + (size_t)g * 128 * S + 64 * m, S, true);
            __syncthreads();
#pragma unroll 1
            for (int grp = 0; grp < 2; ++grp) {
                f32x4 s0, s1; ns_qk(lds, grp, qf, lane, s0, s1);
                const int kb = 64 * m + 32 * grp + 8 * quad;
#pragma unroll
                for (int r = 0; r < 4; ++r) { const int d0 = t - (kb + r), d1 = t - (kb + 4 + r);
                    s0[r] = (d0 >= 0 && d0 < 512) ? __builtin_amdgcn_exp2f(s0[r] * sc2 - cb2) : 0.f; s1[r] = (d1 >= 0 && d1 < 512) ? __builtin_amdgcn_exp2f(s1[r] * sc2 - cb2) : 0.f; }
                l += (s0[0] + s0[1]) + (s0[2] + s0[3]) + (s1[0] + s1[1]) + (s1[2] + s1[3]);
                ns_pv(lds, grp, s0, s1, lane, ob);
            }
        }
        l += __shfl_xor(l, 16); l += __shfl_xor(l, 32);
        const float gw_ = GT[(size_t)t * 24 + 16 + 4 * g + j] / l;
#pragma unroll
        for (int dt = 0; dt < 8; ++dt) otot[dt] += ob[dt] * gw_;
    }
    bf16_t* Y = (bf16_t*)(ws + WS_HB) + (size_t)t * DM + 512 * g + 128 * j + 4 * quad;
#pragma unroll
    for (int dt = 0; dt < 8; ++dt) { u32x2 o; o.x = cvt_pk_bf16(otot[dt][0], otot[dt][1]); o.y = cvt_pk_bf16(otot[dt][2], otot[dt][3]); *(u32x2*)(Y + 16 * dt) = o; }
    __syncthreads();
}

__device__ __forceinline__ void rwkv_scan(const Params& p, LAS unsigned char* lds) {
    unsigned char* ws = p.ws; const int tid = threadIdx.x, lane = tid & 63, w = tid >> 6;
    const int h = blockIdx.x >> 1, half = blockIdx.x & 1;
    const bf16_t* U = (const bf16_t*)(ws + WS_U); const bf16_t* RWX = (const bf16_t*)((unsigned char*)p.out + DO_RWX);
    bf16_t* YB = (bf16_t*)(ws + WS_YB);
    const int ss = tid >> 4, j0 = 4 * (tid & 15);
    float kkw[4], kaw[4], mur[4], muk[4], muv[4];
#pragma unroll
    for (int i = 0; i < 4; ++i) { kkw[i] = p.in[16][h * 64 + j0 + i]; kaw[i] = p.in[17][h * 64 + j0 + i]; mur[i] = p.in[10][h * 64 + j0 + i]; muk[i] = p.in[10][1024 + h * 64 + j0 + i]; muv[i] = p.in[10][2048 + h * 64 + j0 + i]; }
    const int iloc = 4 * w + (lane >> 4), irow = 32 * half + iloc, jj = 4 * (lane & 15);
    float S0 = 0.f, S1 = 0.f, S2 = 0.f, S3 = 0.f;
    LAS float* ybuf = (LAS float*)(lds + 98304);
    u32x2 rc, rp, kc, kp, vc, vp, lw, aa;
    auto stage_load = [&](int chunk) {
        const int t = 32 * chunk + ss; const bf16_t* u = U + (size_t)t * UC + 2584 + h * 64 + j0; const u32x2 z = {0u, 0u};
        rc = *(const u32x2*)u; kc = *(const u32x2*)(u + 1024); vc = *(const u32x2*)(u + 2048);
        if (t > 0) { rp = *(const u32x2*)(u - UC); kp = *(const u32x2*)(u - UC + 1024); vp = *(const u32x2*)(u - UC + 2048); } else { rp = z; kp = z; vp = z; }
        lw = *(const u32x2*)(RWX + (size_t)t * 3072 + h * 64 + j0); aa = *(const u32x2*)(RWX + (size_t)t * 3072 + 1024 + h * 64 + j0);
    };
    auto unpack = [&](u32x2 v, float (&o)[4]) { o[0] = bf2f((bf16_t)(v.x & 0xffff)); o[1] = bf2f((bf16_t)(v.x >> 16)); o[2] = bf2f((bf16_t)(v.y & 0xffff)); o[3] = bf2f((bf16_t)(v.y >> 16)); };
    auto stage_write = [&](int buf) {
        float a[4], b[4], r[4], k[4], v[4], lwf[4], aaf[4];
        unpack(rc, a); unpack(rp, b);
#pragma unroll
        for (int i = 0; i < 4; ++i) r[i] = a[i] + (b[i] - a[i]) * mur[i];
        unpack(kc, a); unpack(kp, b);
#pragma unroll
        for (int i = 0; i < 4; ++i) k[i] = a[i] + (b[i] - a[i]) * muk[i];
        unpack(vc, a); unpack(vp, b);
#pragma unroll
        for (int i = 0; i < 4; ++i) v[i] = a[i] + (b[i] - a[i]) * muv[i];
        unpack(lw, lwf); unpack(aa, aaf);
        float kk[4], sq = 0.f;
#pragma unroll
        for (int i = 0; i < 4; ++i) { kk[i] = k[i] * kkw[i]; sq += kk[i] * kk[i]; }
        sq = row16_sum(sq); const float kn = 1.0f / fmaxf(sqrtf(sq), 1e-12f);
        f32x4 W_, A_, B_, K_, R_, V_;
#pragma unroll
        for (int i = 0; i < 4; ++i) { const float kki = kk[i] * kn; W_[i] = expf(lwf[i]); A_[i] = -kki; B_[i] = kki * aaf[i]; K_[i] = k[i] * (1.0f + (aaf[i] - 1.0f) * kaw[i]); R_[i] = r[i]; V_[i] = v[i]; }
        LAS unsigned char* bp = lds + buf * 49152 + (ss * 64 + j0) * 4;
        *(LAS f32x4*)(bp) = W_; *(LAS f32x4*)(bp + 8192) = A_; *(LAS f32x4*)(bp + 16384) = B_; *(LAS f32x4*)(bp + 24576) = K_; *(LAS f32x4*)(bp + 32768) = R_; *(LAS f32x4*)(bp + 40960) = V_;
    };
    stage_load(0); stage_write(0); __syncthreads();
    for (int chunk = 0; chunk < 512; ++chunk) {
        if (chunk + 1 < 512) stage_load(chunk + 1);
        LAS unsigned char* bp = lds + (chunk & 1) * 49152;
#pragma unroll 4
        for (int s = 0; s < 32; ++s) {
            const f32x4 W_ = *(const LAS f32x4*)(bp + (s * 64 + jj) * 4), A_ = *(const LAS f32x4*)(bp + 8192 + (s * 64 + jj) * 4), B_ = *(const LAS f32x4*)(bp + 16384 + (s * 64 + jj) * 4);
            const f32x4 K_ = *(const LAS f32x4*)(bp + 24576 + (s * 64 + jj) * 4), R_ = *(const LAS f32x4*)(bp + 32768 + (s * 64 + jj) * 4);
            const float v = *(const LAS float*)(bp + 40960 + (s * 64 + irow) * 4);
            const float sa = row16_sum((S0 * A_[0] + S1 * A_[1]) + (S2 * A_[2] + S3 * A_[3]));
            S0 = S0 * W_[0] + (sa * B_[0] + v * K_[0]); S1 = S1 * W_[1] + (sa * B_[1] + v * K_[1]); S2 = S2 * W_[2] + (sa * B_[2] + v * K_[2]); S3 = S3 * W_[3] + (sa * B_[3] + v * K_[3]);
            const float y = row16_sum((S0 * R_[0] + S1 * R_[1]) + (S2 * R_[2] + S3 * R_[3]));
            if ((lane & 15) == 0) ybuf[s * 32 + iloc] = y;
        }
        __syncthreads();
        if (chunk + 1 < 512) stage_write((chunk + 1) & 1);
        { const int pr = tid & 15; const float y0 = ybuf[ss * 32 + 2 * pr], y1 = ybuf[ss * 32 + 2 * pr + 1];
          *(unsigned*)(YB + (size_t)(32 * chunk + ss) * 1024 + h * 64 + 32 * half + 2 * pr) = cvt_pk_bf16(y0, y1); }
        __syncthreads();
    }
}
__device__ __forceinline__ void phase_mix0(const Params& p, LAS unsigned char* lds) {
    if (blockIdx.x < 32) rwkv_scan(p, lds);
    unsigned* ctl = (unsigned*)(p.ws + WS_SMALL + 2048); LAS int* itemw = (LAS int*)(lds + NS_ITEM);
    for (;;) {
        __syncthreads();
        if (threadIdx.x == 0) *itemw = (int)atomicAdd(ctl, 1u);
        __syncthreads();
        const int item = *itemw;
        if (item >= 1024) break;
        nsa_item(p, lds, item);
    }
}
__device__ __forceinline__ void phase_rwfin(const Params& p) {
    unsigned char* ws = p.ws; const int lane = threadIdx.x & 63, gw = blockIdx.x * 8 + (threadIdx.x >> 6), NGW = gridDim.x * 8;
    const bf16_t* U = (const bf16_t*)(ws + WS_U); const bf16_t* RWX = (const bf16_t*)((unsigned char*)p.out + DO_RWX);
    const bf16_t* YB = (const bf16_t*)(ws + WS_YB); bf16_t* Y = (bf16_t*)(ws + WS_HB);
    const float* mu = p.in[10];
    for (int t = gw; t < S; t += NGW) {
        for (int h = 0; h < 16; ++h) { const int cix = h * 64 + lane; const bf16_t* u = U + (size_t)t * UC + 2584 + cix;
            const float y = bf2f(YB[(size_t)t * 1024 + cix]);
            const float mean = wave_sum(y) * (1.0f / 64.f); const float dy = y - mean; const float var = wave_sum(dy * dy) * (1.0f / 64.f);
            const float yn = dy * rsqrtf(var + 64e-5f) * p.in[19][cix] + p.in[20][cix];
            float rc = bf2f(u[0]), kc = bf2f(u[1024]), vc = bf2f(u[2048]), rp = 0.f, kp = 0.f, vp = 0.f;
            if (t > 0) { rp = bf2f(u[-UC]); kp = bf2f(u[1024 - UC]); vp = bf2f(u[2048 - UC]); }
            const float r = rc + (rp - rc) * mu[cix], k = kc + (kp - kc) * mu[1024 + cix], v = vc + (vp - vc) * mu[2048 + cix];
            const float a = bf2f(RWX[(size_t)t * 3072 + 1024 + cix]); const float kf = k * (1.0f + (a - 1.0f) * p.in[17][cix]);
            const float bonus = wave_sum(r * kf * p.in[18][cix]) * v;
            Y[(size_t)t * DM + 1024 + cix] = f2bf((yn + bonus) * bf2f(RWX[(size_t)t * 3072 + 2048 + cix])); }
    }
}
__device__ __forceinline__ float silu_f(float x) { return x / (1.0f + expf(-x)); }
__device__ __forceinline__ float gelu_tanh(float x) { const float u = 0.7978845608028654f * (x + 0.044715f * x * x * x); return 0.5f * x * (1.0f + tanhf(u)); }
__device__ __forceinline__ void phase_conv(const Params& p) {
    unsigned char* ws = p.ws; const bf16_t* U = (const bf16_t*)(ws + WS_U); bf16_t* XCB = (bf16_t*)(ws + WS_HB);
    const float *cw = p.in[23], *cbias = p.in[24];
    for (int idx = blockIdx.x * 512 + threadIdx.x; idx < S * 256; idx += gridDim.x * 512) { const int t = idx >> 8, c = (idx & 255) * 4; float acc[4];
#pragma unroll
        for (int i = 0; i < 4; ++i) acc[i] = cbias[c + i];
#pragma unroll
        for (int w = 0; w < 4; ++w) { const int tt = t - 3 + w; if (tt < 0) continue; const u32x2 x = *(const u32x2*)(U + (size_t)tt * UC + 1024 + c);
            acc[0] += cw[w * 1024 + c] * bf2f((bf16_t)(x.x & 0xffff)); acc[1] += cw[w * 1024 + c + 1] * bf2f((bf16_t)(x.x >> 16)); acc[2] += cw[w * 1024 + c + 2] * bf2f((bf16_t)(x.y & 0xffff)); acc[3] += cw[w * 1024 + c + 3] * bf2f((bf16_t)(x.y >> 16)); }
        u32x2 o; o.x = cvt_pk_bf16(acc[0], acc[1]); o.y = cvt_pk_bf16(acc[2], acc[3]); *(u32x2*)(XCB + (size_t)t * 1024 + c) = o; }
}
__device__ __forceinline__ void lru_chunk(const Params& p, bool apply) {
    unsigned char* ws = p.ws;
    bf16_t* RG = (bf16_t*)((unsigned char*)p.out + DO_RG); const bf16_t* XCB = (const bf16_t*)(ws + WS_HB);
    float* LP = (float*)(ws + WS_LRUP); float* LH = (float*)(ws + WS_LRUH); const bf16_t* U = (const bf16_t*)(ws + WS_U); bf16_t* Y = (bf16_t*)(ws + WS_HB);
    for (int gid = blockIdx.x * 512 + threadIdx.x; gid < 256 * 512; gid += gridDim.x * 512) {
        const int c = gid >> 9, ch = (gid & 511) * 2;
        float h0 = 0.f, h1 = 0.f, sl0 = 0.f, sl1 = 0.f;
        if (apply) { h0 = LH[c * 1024 + ch]; h1 = LH[c * 1024 + ch + 1]; }
        const float ba0 = p.in[26][ch], ba1 = p.in[26][ch + 1], bx0 = p.in[28][ch], bx1 = p.in[28][ch + 1], sp0 = softplusf(-p.in[29][ch]), sp1 = softplusf(-p.in[29][ch + 1]);
#pragma unroll 4
        for (int i = 0; i < 64; ++i) { const size_t t = (size_t)c * 64 + i; u32x2* pp = (u32x2*)(RG + t * 2048 + 2 * ch); const u32x2 x = *pp;
            float la0, b0, la1, b1;
            if (!apply) { const unsigned xc2 = *(const unsigned*)(XCB + t * 1024 + ch);
                const float r0 = sigm(bf2f((bf16_t)(x.x & 0xffff)) + ba0), i0 = sigm(bf2f((bf16_t)(x.x >> 16)) + bx0), r1 = sigm(bf2f((bf16_t)(x.y & 0xffff)) + ba1), i1 = sigm(bf2f((bf16_t)(x.y >> 16)) + bx1);
                la0 = -8.f * r0 * sp0; la1 = -8.f * r1 * sp1;
                b0 = sqrtf(-expm1f(2.f * la0)) * i0 * bf2f((bf16_t)(xc2 & 0xffff)); b1 = sqrtf(-expm1f(2.f * la1)) * i1 * bf2f((bf16_t)(xc2 >> 16));
                u32x2 o; o.x = cvt_pk_bf16(la0, b0); o.y = cvt_pk_bf16(la1, b1); *pp = o;
                la0 = bf2f((bf16_t)(o.x & 0xffff)); b0 = bf2f((bf16_t)(o.x >> 16)); la1 = bf2f((bf16_t)(o.y & 0xffff)); b1 = bf2f((bf16_t)(o.y >> 16)); }
            else { la0 = bf2f((bf16_t)(x.x & 0xffff)); b0 = bf2f((bf16_t)(x.x >> 16)); la1 = bf2f((bf16_t)(x.y & 0xffff)); b1 = bf2f((bf16_t)(x.y >> 16)); }
            h0 = expf(la0) * h0 + b0; h1 = expf(la1) * h1 + b1; sl0 += la0; sl1 += la1;
            if (apply) { const unsigned gi = *(const unsigned*)(U + t * UC + ch); *(unsigned*)(Y + t * DM + ch) = cvt_pk_bf16(h0 * gelu_tanh(bf2f((bf16_t)(gi & 0xffff))), h1 * gelu_tanh(bf2f((bf16_t)(gi >> 16)))); } }
        if (!apply) { LP[c * 1024 + ch] = expf(sl0); LP[c * 1024 + ch + 1] = expf(sl1); LH[c * 1024 + ch] = h0; LH[c * 1024 + ch + 1] = h1; }
    }
}
__device__ __forceinline__ void lru_carry(const Params& p, int chn) {
    float* LP = (float*)(p.ws + WS_LRUP); float* LH = (float*)(p.ws + WS_LRUH); float carry = 0.f;
    for (int c0 = 0; c0 < 256; c0 += 8) { float pv[8], hv[8];
#pragma unroll
        for (int i = 0; i < 8; ++i) { pv[i] = LP[(c0 + i) * 1024 + chn]; hv[i] = LH[(c0 + i) * 1024 + chn]; }
#pragma unroll
        for (int i = 0; i < 8; ++i) { LH[(c0 + i) * 1024 + chn] = carry; carry = pv[i] * carry + hv[i]; } }
}
constexpr int HG_BC = 0, HG_KT = 32768, HG_VT = 51200;
constexpr int HC_QIN = 32768, HC_QI = 50176, HC_KI = 67584, HC_VT = 111104, HC_ATT = 129536, HC_RED = 138752;
__device__ __forceinline__ void hg_bcum(const Params& p, LAS unsigned char* lds, int c, int h, float lower, int k, int q4) {
    const bf16_t* U = (const bf16_t*)(p.ws + WS_U); LAS float* BC = (LAS float*)(lds + HG_BC);
    for (int t = q4 * 16; t < q4 * 16 + 16; ++t) { const float f = bf2f(U[(size_t)(64 * c + t) * UC + 3072 + 128 * h + k]); BC[t * 128 + k] = logf(lower + (1.0f - lower) * sigm(f)); }
    __syncthreads();
    if (threadIdx.x < 128) { float run = 0.f; for (int t = 0; t < 64; ++t) { run += BC[t * 128 + k]; BC[t * 128 + k] = run; } }
    __syncthreads();
}
__device__ __forceinline__ void hgrn_a(const Params& p, LAS unsigned char* lds) {
    unsigned char* ws = p.ws; const int tid = threadIdx.x, lane = tid & 63, w = tid >> 6, k = tid & 127, q4 = tid >> 7, li = lane & 15, quad = lane >> 4;
    const bf16_t* U = (const bf16_t*)(ws + WS_U); bf16_t* HGS = (bf16_t*)((unsigned char*)p.out + DO_HGS); float* HGD = (float*)(ws + WS_HGD);
    LAS float* BC = (LAS float*)(lds + HG_BC);
    for (int item = blockIdx.x; item < 2048; item += gridDim.x) { const int c = item >> 3, h = item & 7;
        const float lower = sigm(p.in[30][1024 + 128 * h + k] - p.in[30][128 * h + k]);
        hg_bcum(p, lds, c, h, lower, k, q4);
        const float blast = BC[63 * 128 + k];
        for (int t = q4 * 16; t < q4 * 16 + 16; ++t) { const bf16_t* u = U + (size_t)(64 * c + t) * UC + 128 * h + k;
            const float forget = lower + (1.0f - lower) * sigm(bf2f(u[3072]));
            *(LAS bf16_t*)(lds + HG_KT + (k * 72 + t) * 2) = f2bf((1.0f - forget) * expf(blast - BC[t * 128 + k]));
            *(LAS bf16_t*)(lds + HG_VT + (k * 72 + t) * 2) = u[4096]; }
        if (tid < 128) HGD[(size_t)(c * 8 + h) * 128 + k] = expf(blast);
        __syncthreads();
        bf16x8 av[2];
#pragma unroll
        for (int ks = 0; ks < 2; ++ks) av[ks] = *(const LAS bf16x8*)(lds + HG_VT + (16 * w + li) * 144 + (32 * ks + 8 * quad) * 2);
#pragma unroll
        for (int kt = 0; kt < 8; ++kt) { f32x4 acc = {0.f, 0.f, 0.f, 0.f};
#pragma unroll
            for (int ks = 0; ks < 2; ++ks) { const bf16x8 b = *(const LAS bf16x8*)(lds + HG_KT + (16 * kt + li) * 144 + (32 * ks + 8 * quad) * 2); acc = MFMA16(av[ks], b, acc); }
#pragma unroll
            for (int r = 0; r < 4; ++r) HGS[((size_t)(c * 8 + h) * 128 + 16 * w + 4 * quad + r) * 128 + 16 * kt + li] = f2bf(acc[r]); }
        __syncthreads();
    }
}
__device__ __forceinline__ void hgrn_b(const Params& p) {
    for (int e = blockIdx.x * 512 + threadIdx.x; e < 65536; e += gridDim.x * 512) {
    unsigned* HG = (unsigned*)((unsigned char*)p.out + DO_HGS); const float* HGD = (const float*)(p.ws + WS_HGD);
    const int h = e >> 13, k = (e & 63) * 2; float r0 = 0.f, r1 = 0.f;
    for (int c0 = 0; c0 < 256; c0 += 8) { unsigned lv[8]; float d0[8], d1[8];
#pragma unroll
        for (int i = 0; i < 8; ++i) { lv[i] = HG[(size_t)(c0 + i) * 65536 + e]; d0[i] = HGD[(size_t)((c0 + i) * 8 + h) * 128 + k]; d1[i] = HGD[(size_t)((c0 + i) * 8 + h) * 128 + k + 1]; }
#pragma unroll
        for (int i = 0; i < 8; ++i) { HG[(size_t)(c0 + i) * 65536 + e] = cvt_pk_bf16(r0, r1); r0 = d0[i] * r0 + bf2f((bf16_t)(lv[i] & 0xffff)); r1 = d1[i] * r1 + bf2f((bf16_t)(lv[i] >> 16)); } }
    }
}
__device__ __forceinline__ void hgrn_c(const Params& p, LAS unsigned char* lds) {
    unsigned char* ws = p.ws; const int tid = threadIdx.x, lane = tid & 63, w = tid >> 6, k = tid & 127, q4 = tid >> 7, li = lane & 15, quad = lane >> 4;
    const bf16_t* U = (const bf16_t*)(ws + WS_U); const bf16_t* HGS = (const bf16_t*)((unsigned char*)p.out + DO_HGS); bf16_t* Y = (bf16_t*)(ws + WS_HB);
    LAS float* BC = (LAS float*)(lds + HG_BC); LAS float* RED = (LAS float*)(lds + HC_RED);
    for (int item = blockIdx.x; item < 2048; item += gridDim.x) { const int c = item >> 3, h = item & 7;
        const float lower = sigm(p.in[30][1024 + 128 * h + k] - p.in[30][128 * h + k]);
        hg_bcum(p, lds, c, h, lower, k, q4);
        for (int i = tid; i < 576; i += 512) *(LAS u32x4*)(lds + HC_ATT + i * 16) = (u32x4){0u, 0u, 0u, 0u};
        for (int t = q4 * 16; t < q4 * 16 + 16; ++t) { const bf16_t* u = U + (size_t)(64 * c + t) * UC + 128 * h + k;
            const float bc = BC[t * 128 + k], bref = q4 > 0 ? BC[(16 * q4 - 1) * 128 + k] : 0.f;
            const float qv = silu_f(bf2f(u[2048])), kh = 1.0f - (lower + (1.0f - lower) * sigm(bf2f(u[3072])));
            *(LAS bf16_t*)(lds + HC_QIN + (t * 136 + k) * 2) = f2bf(qv * expf(bc));
            *(LAS bf16_t*)(lds + HC_QI + (t * 136 + k) * 2) = f2bf(qv * expf(bc - bref));
            *(LAS bf16_t*)(lds + HC_VT + (k * 72 + t) * 2) = u[4096];
            for (int I = q4; I < 4; ++I) { const float br = I > 0 ? BC[(16 * I - 1) * 128 + k] : 0.f; const int ro = (I == 0 ? 0 : (I == 1 ? 16 : (I == 2 ? 48 : 96)));
                *(LAS bf16_t*)(lds + HC_KI + ((ro + t) * 136 + k) * 2) = f2bf(kh * expf(fminf(br - bc, 80.f))); } }
        __syncthreads();
        for (int ti = w; ti < 10; ti += 8) {
            const int I = ti < 1 ? 0 : (ti < 3 ? 1 : (ti < 6 ? 2 : 3)), J = ti - (I == 0 ? 0 : (I == 1 ? 1 : (I == 2 ? 3 : 6))), ro = (I == 0 ? 0 : (I == 1 ? 16 : (I == 2 ? 48 : 96)));
            f32x4 acc = {0.f, 0.f, 0.f, 0.f};
#pragma unroll
            for (int ks = 0; ks < 4; ++ks) { const bf16x8 a = *(const LAS bf16x8*)(lds + HC_QI + (16 * I + li) * 272 + (32 * ks + 8 * quad) * 2), b = *(const LAS bf16x8*)(lds + HC_KI + (ro + 16 * J + li) * 272 + (32 * ks + 8 * quad) * 2); acc = MFMA16(a, b, acc); }
#pragma unroll
            for (int r = 0; r < 4; ++r) { const int t = 16 * I + 4 * quad + r, s = 16 * J + li; *(LAS bf16_t*)(lds + HC_ATT + (t * 72 + s) * 2) = f2bf(s <= t ? acc[r] : 0.f); } }
        __syncthreads();
        f32x4 o[4];
#pragma unroll
        for (int tt = 0; tt < 4; ++tt) o[tt] = (f32x4){0.f, 0.f, 0.f, 0.f};
#pragma unroll
        for (int ks = 0; ks < 4; ++ks) { const bf16x8 a = *(const bf16x8*)(HGS + ((size_t)(c * 8 + h) * 128 + 16 * w + li) * 128 + 32 * ks + 8 * quad);
#pragma unroll
            for (int tt = 0; tt < 4; ++tt) { const bf16x8 b = *(const LAS bf16x8*)(lds + HC_QIN + (16 * tt + li) * 272 + (32 * ks + 8 * quad) * 2); o[tt] = MFMA16(a, b, o[tt]); } }
#pragma unroll
        for (int ks = 0; ks < 2; ++ks) { const bf16x8 a = *(const LAS bf16x8*)(lds + HC_VT + (16 * w + li) * 144 + (32 * ks + 8 * quad) * 2);
#pragma unroll
            for (int tt = 0; tt < 4; ++tt) { const bf16x8 b = *(const LAS bf16x8*)(lds + HC_ATT + (16 * tt + li) * 144 + (32 * ks + 8 * quad) * 2); o[tt] = MFMA16(a, b, o[tt]); } }
#pragma unroll
        for (int tt = 0; tt < 4; ++tt) { float sq = (o[tt][0] * o[tt][0] + o[tt][1] * o[tt][1]) + (o[tt][2] * o[tt][2] + o[tt][3] * o[tt][3]); sq += __shfl_xor(sq, 16); sq += __shfl_xor(sq, 32); if (quad == 0) RED[w * 64 + 16 * tt + li] = sq; }
        __syncthreads();
#pragma unroll
        for (int tt = 0; tt < 4; ++tt) { float tot = 0.f;
#pragma unroll
            for (int ww = 0; ww < 8; ++ww) tot += RED[ww * 64 + 16 * tt + li];
            const float rinv = rsqrtf(tot * (1.0f / 128.f) + 1e-6f); const int t = 64 * c + 16 * tt + li, vcol = 128 * h + 16 * w + 4 * quad;
            const u32x2 gp = *(const u32x2*)(U + (size_t)t * UC + 5120 + vcol); const f32x4 ng = *(const f32x4*)(p.in[31] + vcol);
            const float g0 = bf2f((bf16_t)(gp.x & 0xffff)), g1 = bf2f((bf16_t)(gp.x >> 16)), g2 = bf2f((bf16_t)(gp.y & 0xffff)), g3 = bf2f((bf16_t)(gp.y >> 16));
            u32x2 ov; ov.x = cvt_pk_bf16(o[tt][0] * rinv * ng[0] * silu_f(g0), o[tt][1] * rinv * ng[1] * silu_f(g1)); ov.y = cvt_pk_bf16(o[tt][2] * rinv * ng[2] * silu_f(g2), o[tt][3] * rinv * ng[3] * silu_f(g3));
            *(u32x2*)(Y + (size_t)t * DM + 1024 + vcol) = ov; }
        __syncthreads();
    }
}
#ifndef MASK
#define MASK 0xFFFFFFFF
#endif
#define PH(n) (((MASK) >> (n)) & 1)
template <class T> __device__ __forceinline__ T* uni_ptr(T* ptr) { const unsigned long long v = (unsigned long long)ptr; const unsigned lo = __builtin_amdgcn_readfirstlane((unsigned)v), hi = __builtin_amdgcn_readfirstlane((unsigned)(v >> 32)); return (T*)(((unsigned long long)hi << 32) | lo); }
__global__ void __launch_bounds__(512) mk_forward(const Params kp) {
    extern __shared__ __attribute__((aligned(16))) unsigned char shm[];
    LAS unsigned char* lds = (LAS unsigned char*)shm;
    unsigned char* ws = kp.ws; unsigned char* dob = (unsigned char*)kp.out; const int lo = kp.ph_lo, hi = kp.ph_hi;
    { LAS Params* lp = (LAS Params*)(lds + LDS_BYTES - 512);
      if (threadIdx.x < 32) lp->in[threadIdx.x] = nullptr;
      __syncthreads();
      if (threadIdx.x == 0) {
#pragma unroll
          for (int i = 0; i < 32; ++i) lp->in[i] = kp.in[i];
          lp->out = (float*)dob; lp->ws = ws; lp->ph_lo = lo; lp->ph_hi = hi; }
      __syncthreads(); }
    const Params& p = *(const Params*)(shm + LDS_BYTES - 512);
    bf16_t *WIN = (bf16_t*)(ws + WS_WIN), *WOUT = (bf16_t*)(ws + WS_WOUT), *W1 = (bf16_t*)(ws + WS_W1), *W2 = (bf16_t*)(ws + WS_W2), *HB = (bf16_t*)(ws + WS_HB), *UB = (bf16_t*)(ws + WS_U), *ZB = (bf16_t*)(ws + WS_Z);
    float* X2 = (float*)(ws + WS_X2);
#define PHASE(k, ...) if (PH(k) && lo <= (k) && (k) < hi) { if ((k) > lo) cg::this_grid().sync(); __VA_ARGS__ }
    PHASE(0, phase_prep0(p, lds);)
    PHASE(1, run_gemm(lds, HB, DM, WIN, DM, S, UC, DM, EpiBf16<0>{UB, UC});)
    PHASE(2, phase_tok0(p, lds);)
    PHASE(3, run_gemm(lds, (const bf16_t*)(ws + WS_ALORA), 512, (const bf16_t*)(ws + WS_LORA), 512, S, 3072, 512, EpiBf16<0>{(bf16_t*)(dob + DO_RWX), 3072});)
    if (PH(3) && lo <= 3 && 3 < hi) { run_gemm(lds, (const bf16_t*)(ws + WS_KCVC), 2048, (const bf16_t*)(ws + WS_CMPW), 4096, 4096, 256, 4096, EpiF32{(float*)(ws + WS_CMPC), 256}); }
    PHASE(4, phase_cmpfin(p, lds);)
    PHASE(5, phase_mix0(p, lds);)
    PHASE(6, phase_rwfin(p);)
    PHASE(7, run_gemm(lds, HB, DM, WOUT, DM, S, DM, DM, EpiResid{uni_ptr(p.in[0]), kp.out});)
    PHASE(8, rmsnorm_rows(p.out, p.in[2], HB, S);)
    PHASE(9, run_gemm(lds, HB, DM, W1, DM, 8192, FF, DM, EpiBf16<1>{ZB, FF});)
    PHASE(10, run_gemm(lds, ZB, FF, W2, FF, 8192, DM, FF, EpiResid{kp.out, X2});)
    PHASE(11, run_gemm(lds, HB + (size_t)8192 * DM, DM, W1, DM, 8192, FF, DM, EpiBf16<1>{ZB, FF});)
    PHASE(12, run_gemm(lds, ZB, FF, W2, FF, 8192, DM, FF, EpiResid{kp.out + (size_t)8192 * DM, X2 + (size_t)8192 * DM});)
    PHASE(13, phase_prep1(p, lds);)
    PHASE(14, run_gemm(lds, HB, DM, WIN, DM, S, UC, DM, EpiBf16<0>{UB, UC});)
    PHASE(15, phase_conv(p);)
    PHASE(16, run_gemm(lds, HB, 1024, (const bf16_t*)(ws + WS_LRUG), 1024, S, 2048, 1024, EpiBf16<0>{(bf16_t*)(dob + DO_RG), 2048});)
    PHASE(17, lru_chunk(p, false); hgrn_a(p, lds);)
    PHASE(18, if (blockIdx.x >= gridDim.x - 2) lru_carry(p, (int)(blockIdx.x - (gridDim.x - 2)) * 512 + (int)threadIdx.x); else hgrn_b(p);)
    PHASE(19, lru_chunk(p, true); hgrn_c(p, lds);)
    PHASE(20, run_gemm(lds, HB, DM, WOUT, DM, S, DM, DM, EpiResid{X2, kp.out});)
    PHASE(21, rmsnorm_rows(p.out, p.in[2] + DM, HB, S);)
    PHASE(22, run_gemm(lds, HB, DM, W1, DM, 8192, FF, DM, EpiBf16<1>{ZB, FF});)
    PHASE(23, run_gemm(lds, ZB, FF, W2, FF, 8192, DM, FF, EpiResid{kp.out, kp.out});)
    PHASE(24, run_gemm(lds, HB + (size_t)8192 * DM, DM, W1, DM, 8192, FF, DM, EpiBf16<1>{ZB, FF});)
    PHASE(25, run_gemm(lds, ZB, FF, W2, FF, 8192, DM, FF, EpiResid{kp.out + (size_t)8192 * DM, kp.out + (size_t)8192 * DM});)
#undef PHASE
}

extern "C" void kernel_launch(void* const* d_in, const int* in_sizes, int n_in, void* d_out, int out_size, void* d_ws, size_t ws_size, hipStream_t stream) {
    static int grid = 0;
    if (grid == 0) {
        if (n_in != 32 || out_size != S * DM || ws_size < WS_END) { fprintf(stderr, "kernel_launch: unexpected problem (n_in %d out %d ws %zu)\n", n_in, out_size, ws_size); grid = -1; return; }
        int dev = 0, cus = 0, per_cu = 0;
        hipGetDevice(&dev); hipDeviceGetAttribute(&cus, hipDeviceAttributeMultiprocessorCount, dev);
        if (hipFuncSetAttribute((const void*)mk_forward, hipFuncAttributeMaxDynamicSharedMemorySize, LDS_BYTES) != hipSuccess) { fprintf(stderr, "kernel_launch: hipFuncSetAttribute failed\n"); grid = -1; return; }
        if (hipOccupancyMaxActiveBlocksPerMultiprocessor(&per_cu, (const void*)mk_forward, 512, LDS_BYTES) != hipSuccess || per_cu < 1) { fprintf(stderr, "kernel_launch: occupancy query says %d\n", per_cu); per_cu = 1; }
        (void)hipGetLastError();
        grid = cus * 1;
        fprintf(stderr, "kernel_launch: cus %d per_cu %d grid %d\n", cus, per_cu, grid);
    }
    if (grid < 0) return;
    Params p{};
    for (int i = 0; i < 32; ++i) p.in[i] = (const float*)d_in[i];
    p.out = (float*)d_out; p.ws = (unsigned char*)d_ws;
#if MK_PER_PHASE
    for (int ph = 0; ph < NPHASE; ++ph) { p.ph_lo = ph; p.ph_hi = ph + 1; hipLaunchKernelGGL(mk_forward, dim3(grid), dim3(512), LDS_BYTES, stream, p); }
#else
    p.ph_lo = 0; p.ph_hi = NPHASE;
    void* args[] = {(void*)&p};
    hipError_t e = hipLaunchCooperativeKernel((const void*)mk_forward, dim3(grid), dim3(512), args, LDS_BYTES, stream);
    if (e != hipSuccess) fprintf(stderr, "cooperative launch failed: %s (grid %d)\n", hipGetErrorString(e), grid);
#endif
}
```

```cpp
#include <hip/hip_runtime.h>
#include <hip/hip_cooperative_groups.h>
#include <cstdio>
namespace cg = cooperative_groups;
#ifndef MK_PER_PHASE
#define MK_PER_PHASE 0
#endif
namespace pg8 {
#define PG8_LAS __attribute__((address_space(3)))
typedef unsigned short bf16_t;
typedef short bf16x8 __attribute__((ext_vector_type(8)));
typedef float f32x4 __attribute__((ext_vector_type(4)));
typedef unsigned u32x4 __attribute__((ext_vector_type(4)));
constexpr int BM = 256, BK = 64, HALF = 128, HTB = HALF * BK * 2  , STAGE_BYTES = 8 * HTB, NXCD = 8, WGM = 8;

__host__ __device__ __forceinline__ int lds_byte(int r, int c) { const int st = (r >> 4) * 2 + (c >> 5), rr = r & 15, cc = c & 31, ob = rr * 64 + cc * 2; return st * 1024 + (ob ^ (((ob >> 9) & 1) << 5)); }
__host__ __device__ __forceinline__ void stage_rc(int b, int& R, int& C) { const int st = b / 1024, sb = b % 1024, swz = sb ^ (((sb >> 9) & 1) << 5); R = (st >> 1) * 16 + swz / 64; C = (st & 1) * 32 + (swz % 64) / 2; }
__host__ __device__ __forceinline__ int perm32(int rho) { const int n = rho >> 4, i = rho & 15; return 8 * (i >> 2) + 4 * n + (i & 3); }

struct Unit { int pm, pn; };
struct Gemm { const bf16_t* A; const bf16_t* Bt; int M, N, K, lda, ldb; };

struct StaticOrder {
    int nM, nN, nwg, G, c;
    __host__ __device__ void init(int M, int N, int G_, int c_) { nM = M / BM; nN = N / BM; nwg = nM * nN; G = G_; c = c_; }
    __host__ __device__ bool next(int i, Unit& u) const {
        const long L = (long)i * G + c; if (L >= nwg) return false;
        int wgid = (int)L; { const int q = nwg / NXCD, r = nwg % NXCD, xcd = wgid % NXCD, off = wgid / NXCD; wgid = (xcd < r ? xcd * (q + 1) : r * (q + 1) + (xcd - r) * q) + off; }
        const int nig = WGM * nN, gid = wgid / nig, fm = gid * WGM, gsz = (nM - fm) < WGM ? (nM - fm) : WGM;
        u.pm = fm + ((wgid % nig) % gsz); u.pn = (wgid % nig) / gsz; return true;
    }
    __device__ __forceinline__ void a_ready(const Unit&) const {}
    __device__ __forceinline__ void done(const Unit&) const {}
};
__device__ __forceinline__ unsigned cvt_pk_bf16(float lo, float hi) { unsigned r; asm volatile("v_cvt_pk_bf16_f32 %0, %1, %2" : "=v"(r) : "v"(lo), "v"(hi)); return r; }
typedef float f32x2 __attribute__((ext_vector_type(2)));
template <class Epi, class Sched, bool STAMP = false>
__device__ __forceinline__ void gemm_phase(PG8_LAS unsigned char* lds, const Gemm g, const Sched& S, const Epi& E, unsigned long long* stamps) {
    const int tid = threadIdx.x, wid = __builtin_amdgcn_readfirstlane(tid >> 6), lane = tid & 63, wr = wid >> 2, wc = wid & 3, fr = lane & 15, fq = lane >> 4;
    const int K = g.K, nt = K / BK;
    int ts_lo = 0, ts_hi = 0, nts = 0; const unsigned long long rt_entry = STAMP ? (unsigned long long)wall_clock64() : 0ull;
#define PG8_STAMP() do { if (STAMP && wid == 0 && nts < 64) { const unsigned long long _c = (unsigned long long)clock64(); \
        ts_lo = (lane == nts) ? (int)(unsigned)_c : ts_lo; ts_hi = (lane == nts) ? (int)(unsigned)(_c >> 32) : ts_hi; ++nts; } } while (0)
    PG8_STAMP();
    unsigned voffA[2], voffB[2];
#pragma unroll
    for (int i = 0; i < 2; ++i) { int R, C; stage_rc(tid * 16 + i * 8192, R, C); const int Rb = Epi::PERM ? ((R & ~31) + perm32(R & 31)) : R;
        voffA[i] = (unsigned)(R * g.lda + C) * 2u; voffB[i] = (unsigned)(Rb * g.ldb + C) * 2u; }
    const size_t kstep = (size_t)(BK * 2);
    const size_t hstepA = (size_t)HALF * g.lda * 2, hstepB = (size_t)HALF * g.ldb * 2;
    const size_t tstepA = 2 * hstepA, tstepB = 2 * hstepB;
    const unsigned ldsw = (unsigned)wid * 1024u;
    const int aoff = lds_byte(wr * 64 + fr, fq * 8), boff = lds_byte(wc * 32 + fr, fq * 8);
#define PG8_SA(b, h) (((b) * 2 + (h)) * HTB)
#define PG8_SB(b, h) ((4 + (b) * 2 + (h)) * HTB)
#define PG8_STAGE(bufoff, gbase, voff) do { _Pragma("unroll") for (int _i = 0; _i < 2; ++_i) \
        __builtin_amdgcn_global_load_lds((const unsigned*)((const char*)(gbase) + (voff)[_i]), (PG8_LAS unsigned*)(lds + (bufoff) + ldsw + _i * 8192), 16, 0, 0); } while (0)
#define PG8_LDA(dst, b, h) do { _Pragma("unroll") for (int m = 0; m < 4; ++m) _Pragma("unroll") for (int k = 0; k < 2; ++k) dst[m][k] = *(const PG8_LAS bf16x8*)(lds + PG8_SA(b, h) + aoff + m * 2048 + k * 1024); } while (0)
#define PG8_LDB(dst, b, h) do { _Pragma("unroll") for (int n = 0; n < 2; ++n) _Pragma("unroll") for (int k = 0; k < 2; ++k) dst[n][k] = *(const PG8_LAS bf16x8*)(lds + PG8_SB(b, h) + boff + n * 2048 + k * 1024); } while (0)
#define PG8_MMA(ai, bj, At, Bt) do { __builtin_amdgcn_s_setprio(1); _Pragma("unroll") for (int m = 0; m < 4; ++m) _Pragma("unroll") for (int n = 0; n < 2; ++n) _Pragma("unroll") for (int k = 0; k < 2; ++k) \
        acc[ai][bj][m][n] = __builtin_amdgcn_mfma_f32_16x16x32_bf16(Bt[n][k], At[m][k], acc[ai][bj][m][n], 0, 0, 0); __builtin_amdgcn_s_setprio(0); } while (0)
#define PG8_WAIT_V(n) asm volatile("s_waitcnt vmcnt(" #n ")" ::: "memory")
#define PG8_WAIT_L(n) asm volatile("s_waitcnt lgkmcnt(" #n ")" ::: "memory")
#define PG8_BAR __builtin_amdgcn_s_barrier()
#define PG8_SCHED __builtin_amdgcn_sched_barrier(0)
    Unit cur, nxt; int ui = 0;
    if (!S.next(0, cur)) return;
    f32x4 acc[2][2][4][2];
#pragma unroll
    for (int a = 0; a < 2; ++a)
#pragma unroll
        for (int b = 0; b < 2; ++b)
#pragma unroll
            for (int m = 0; m < 4; ++m)
#pragma unroll
                for (int n = 0; n < 2; ++n) acc[a][b][m][n] = (f32x4){0.f, 0.f, 0.f, 0.f};
    bf16x8 At[4][2], B0[2][2], B1[2][2];
    const char* cA = (const char*)g.A + (size_t)cur.pm * tstepA; const char* cB = (const char*)g.Bt + (size_t)cur.pn * tstepB;
    S.a_ready(cur);
    PG8_STAGE(PG8_SB(0, 0), cB, voffB); PG8_STAGE(PG8_SA(0, 0), cA, voffA); PG8_STAGE(PG8_SB(0, 1), cB + hstepB, voffB); PG8_STAGE(PG8_SA(0, 1), cA + hstepA, voffA);
    if (wr == 1) PG8_BAR;
    PG8_WAIT_V(4); PG8_BAR;
    PG8_STAGE(PG8_SB(1, 0), cB + kstep, voffB); PG8_STAGE(PG8_SA(1, 0), cA + kstep, voffA); PG8_STAGE(PG8_SB(1, 1), cB + hstepB + kstep, voffB);
    PG8_WAIT_V(6); PG8_BAR;
    PG8_STAMP();
    for (;;) {
        const bool has_next = S.next(ui + 1, nxt);
        const char* nA = has_next ? (const char*)g.A + (size_t)nxt.pm * tstepA : cA; const char* nB = has_next ? (const char*)g.Bt + (size_t)nxt.pn * tstepB : cB;
        for (int t = 0; t < nt; t += 2) {
            const bool last = (t == nt - 2);
            const char* a1 = cA + (size_t)(t + 1) * kstep;
            const char* a2 = last ? nA : cA + (size_t)(t + 2) * kstep; const char* b2 = last ? nB : cB + (size_t)(t + 2) * kstep;
            const char* a3 = a2 + kstep; const char* b3 = b2 + kstep;
            if (last && has_next) S.a_ready(nxt);
            PG8_LDB(B0, 0, 0); PG8_SCHED; PG8_LDA(At, 0, 0); PG8_STAGE(PG8_SA(1, 1), a1 + hstepA, voffA);
            PG8_WAIT_L(8); PG8_BAR; PG8_WAIT_L(0); PG8_MMA(0, 0, At, B0); PG8_BAR; PG8_SCHED;
            PG8_LDB(B1, 0, 1); PG8_STAGE(PG8_SB(0, 0), b2, voffB);
            PG8_BAR; PG8_WAIT_L(0); PG8_MMA(0, 1, At, B1); PG8_BAR;
            PG8_LDA(At, 0, 1); PG8_STAGE(PG8_SA(0, 0), a2, voffA);
            PG8_BAR; PG8_WAIT_L(0); PG8_MMA(1, 0, At, B0); PG8_BAR; PG8_SCHED;
            PG8_STAGE(PG8_SB(0, 1), b2 + hstepB, voffB);
            PG8_WAIT_V(6); PG8_BAR; PG8_MMA(1, 1, At, B1); PG8_BAR;
            PG8_LDB(B0, 1, 0); PG8_SCHED; PG8_LDA(At, 1, 0); PG8_STAGE(PG8_SA(0, 1), a2 + hstepA, voffA);
            PG8_WAIT_L(8); PG8_BAR; PG8_WAIT_L(0); PG8_MMA(0, 0, At, B0); PG8_BAR; PG8_SCHED;
            PG8_LDB(B1, 1, 1); PG8_STAGE(PG8_SB(1, 0), b3, voffB);
            PG8_BAR; PG8_WAIT_L(0); PG8_MMA(0, 1, At, B1); PG8_BAR;
            PG8_LDA(At, 1, 1); PG8_STAGE(PG8_SA(1, 0), a3, voffA);
            PG8_BAR; PG8_WAIT_L(0); PG8_MMA(1, 0, At, B0); PG8_BAR; PG8_SCHED;
            PG8_STAGE(PG8_SB(1, 1), b3 + hstepB, voffB);
            PG8_WAIT_V(6); PG8_BAR; PG8_MMA(1, 1, At, B1); PG8_BAR;
        }
        PG8_STAMP();
        if constexpr (!Epi::AFTER_DRAIN) { E(acc, cur, wr, wc, fr, fq); S.done(cur); }
        PG8_STAMP();
        if (!has_next) break;
#pragma unroll
        for (int a = 0; a < 2; ++a)
#pragma unroll
            for (int b = 0; b < 2; ++b)
#pragma unroll
                for (int m = 0; m < 4; ++m)
#pragma unroll
                    for (int n = 0; n < 2; ++n) acc[a][b][m][n] = (f32x4){0.f, 0.f, 0.f, 0.f};
        cur = nxt; cA = nA; cB = nB; ++ui;
    }
    PG8_WAIT_V(0);
    if (wr == 0) PG8_BAR;
    PG8_BAR;
    if constexpr (Epi::AFTER_DRAIN) { E.fused(acc, cur, wr, wc, fr, fq, lds, wid, lane); S.done(cur); }
    PG8_STAMP();
    if (STAMP && wid == 0) { stamps[lane] = lane < nts ? (((unsigned long long)(unsigned)ts_hi << 32) | (unsigned)ts_lo) : 0ull;
        if (lane == 62) stamps[62] = rt_entry; if (lane == 63) stamps[63] = (unsigned long long)wall_clock64(); }
#undef PG8_STAMP
#undef PG8_SA
#undef PG8_SB
#undef PG8_STAGE
#undef PG8_LDA
#undef PG8_LDB
#undef PG8_MMA
#undef PG8_WAIT_V
#undef PG8_WAIT_L
#undef PG8_BAR
#undef PG8_SCHED
}
}
using pg8::bf16_t; using pg8::bf16x8; using pg8::f32x4; using pg8::u32x4; using pg8::cvt_pk_bf16;
typedef unsigned u32x2 __attribute__((ext_vector_type(2)));
#define LAS __attribute__((address_space(3)))
constexpr int S = 16384, DM = 2048, FF = 8192, UC = 6144;
constexpr size_t MiB = (size_t)1 << 20;
constexpr size_t WS_WIN = 0, WS_WOUT = 24 * MiB, WS_W1 = 32 * MiB, WS_W2 = 64 * MiB, WS_CMPW = 96 * MiB, WS_LORA = 98 * MiB, WS_LRUG = 96 * MiB, WS_SMALL = 101 * MiB;
constexpr size_t WS_HB = 102 * MiB, WS_X2 = 166 * MiB, WS_U = 294 * MiB, WS_D2 = 486 * MiB, WS_END = 512 * MiB;
constexpr size_t WS_QB = 166 * MiB, WS_KSB = 198 * MiB, WS_KWB = 206 * MiB, WS_KCVC = 214 * MiB, WS_VST = 230 * MiB, WS_VWT = 238 * MiB, WS_YB = 246 * MiB;
constexpr size_t WS_ALORA = 486 * MiB, WS_CMPC = 502 * MiB, WS_GT = 506 * MiB, WS_KCB = 508 * MiB, WS_VCT = 508 * MiB + 512 * 1024;
constexpr size_t WS_LRUP = 486 * MiB, WS_LRUH = 487 * MiB, WS_HGD = 488 * MiB;
constexpr size_t WS_Z = 294 * MiB;
constexpr size_t DO_RWX = 0;
constexpr size_t DO_RG = 0, DO_HGS = 64 * MiB;
constexpr int LDS_BYTES = 144 * 1024;
constexpr int NPHASE = 26;

struct Params { const float* in[32]; float* out; unsigned char* ws; int ph_lo, ph_hi; };

__device__ __forceinline__ float bf2f(bf16_t b) { return __uint_as_float(((unsigned)b) << 16); }
__device__ __forceinline__ bf16_t f2bf(float f) { unsigned u = __float_as_uint(f); u += 0x7FFFu + ((u >> 16) & 1u); return (bf16_t)(u >> 16); }
__device__ __forceinline__ float wave_sum(float v) {
#pragma unroll
    for (int o = 1; o < 64; o <<= 1) v += __shfl_xor(v, o);
    return v;
}
__device__ __forceinline__ float sigm(float x) { return 1.0f / (1.0f + expf(-x)); }
__device__ __forceinline__ float softplusf(float x) { return x > 20.f ? x : log1pf(expf(x)); }
__device__ __forceinline__ float row16_sum(float v) {
    v += __int_as_float(__builtin_amdgcn_update_dpp(0, __float_as_int(v), 0xB1, 0xF, 0xF, true));
    v += __int_as_float(__builtin_amdgcn_update_dpp(0, __float_as_int(v), 0x4E, 0xF, 0xF, true));
    v += __int_as_float(__builtin_amdgcn_update_dpp(0, __float_as_int(v), 0x141, 0xF, 0xF, true));
    v += __int_as_float(__builtin_amdgcn_update_dpp(0, __float_as_int(v), 0x140, 0xF, 0xF, true));
    return v;
}
#define MFMA16(a, b, c) __builtin_amdgcn_mfma_f32_16x16x32_bf16((a), (b), (c), 0, 0, 0)

struct EpiF32 {
    static constexpr bool PERM = false, AFTER_DRAIN = false;
    float* C; int ldc;
    __device__ __forceinline__ void operator()(const f32x4 (&acc)[2][2][4][2], const pg8::Unit& u, int wr, int wc, int fr, int fq) const {
        const int row0 = u.pm * 256 + wr * 64 + fr, col0 = u.pn * 256 + wc * 32 + 4 * fq;
#pragma unroll
        for (int ai = 0; ai < 2; ++ai)
#pragma unroll
            for (int m = 0; m < 4; ++m) { float* rowp = C + (size_t)(row0 + ai * 128 + m * 16) * ldc + col0;
#pragma unroll
                for (int bj = 0; bj < 2; ++bj)
#pragma unroll
                    for (int n = 0; n < 2; ++n) *(f32x4*)(rowp + bj * 128 + n * 16) = acc[ai][bj][m][n]; }
    }
};
struct EpiResid {
    static constexpr bool PERM = false, AFTER_DRAIN = false;
    const float* base; float* out;
    __device__ __forceinline__ void operator()(const f32x4 (&acc)[2][2][4][2], const pg8::Unit& u, int wr, int wc, int fr, int fq) const {
        const int row0 = u.pm * 256 + wr * 64 + fr, col0 = u.pn * 256 + wc * 32 + 4 * fq;
#pragma unroll
        for (int ai = 0; ai < 2; ++ai)
#pragma unroll
            for (int m = 0; m < 4; ++m) { const size_t off = (size_t)(row0 + ai * 128 + m * 16) * DM + col0;
#pragma unroll
                for (int bj = 0; bj < 2; ++bj)
#pragma unroll
                    for (int n = 0; n < 2; ++n) { const f32x4 b = *(const f32x4*)(base + off + bj * 128 + n * 16); *(f32x4*)(out + off + bj * 128 + n * 16) = b + acc[ai][bj][m][n]; }
                asm volatile("" ::: "memory"); }
    }
};
template <int ACT  > struct EpiBf16 {
    static constexpr bool PERM = true, AFTER_DRAIN = false;
    bf16_t* O; int ldc;
    __device__ __forceinline__ void operator()(const f32x4 (&acc)[2][2][4][2], const pg8::Unit& u, int wr, int wc, int fr, int fq) const {
        const int row0 = u.pm * 256 + wr * 64 + fr, col0 = u.pn * 256 + wc * 32 + 8 * fq;
#pragma unroll
        for (int ai = 0; ai < 2; ++ai)
#pragma unroll
            for (int m = 0; m < 4; ++m) { bf16_t* rowp = O + (size_t)(row0 + ai * 128 + m * 16) * ldc + col0;
#pragma unroll
                for (int bj = 0; bj < 2; ++bj) { f32x4 v0 = acc[ai][bj][m][0], v1 = acc[ai][bj][m][1];
                    if (ACT == 1) {
#pragma unroll
                        for (int j = 0; j < 4; ++j) { float a = fmaxf(v0[j], 0.f), b = fmaxf(v1[j], 0.f); v0[j] = a * a; v1[j] = b * b; } }
                    u32x4 w; w.x = cvt_pk_bf16(v0[0], v0[1]); w.y = cvt_pk_bf16(v0[2], v0[3]); w.z = cvt_pk_bf16(v1[0], v1[1]); w.w = cvt_pk_bf16(v1[2], v1[3]);
                    *(u32x4*)(rowp + bj * 128) = w; } }
    }
};
template <class Epi> __device__ __forceinline__ void run_gemm(LAS unsigned char* lds, const bf16_t* A, int lda, const bf16_t* Bt, int ldb, int M, int N, int K, const Epi& E) {
    pg8::Gemm g; g.A = A; g.Bt = Bt; g.M = M; g.N = N; g.K = K; g.lda = lda; g.ldb = ldb;
    pg8::StaticOrder so; so.init(M, N, (int)gridDim.x, (int)blockIdx.x);
    __syncthreads();
    pg8::gemm_phase<Epi, pg8::StaticOrder, false>(lds, g, so, E, nullptr);
    __syncthreads();
}

template <typename SrcT> __device__ __forceinline__ void tconv(const SrcT* src, size_t ld, int K, int N, int Npad, bf16_t* dst, size_t dld, const float* bias, int zero_k, LAS float* tile) {
    const int tid = threadIdx.x, nN = Npad / 64, ntiles = (K / 64) * nN;
    const int r = tid >> 4, c4 = tid & 15;
    float v[2][4];
    auto gload = [&](int id) { const int k0 = (id / nN) * 64, n0 = (id % nN) * 64, n = n0 + 4 * c4;
#pragma unroll
        for (int h = 0; h < 2; ++h) { const int k = k0 + r + 32 * h; v[h][0] = v[h][1] = v[h][2] = v[h][3] = 0.f;
            if (n < N && k != zero_k) {
                if constexpr (sizeof(SrcT) == 4) { const f32x4 x = *(const f32x4*)((const float*)src + (size_t)k * ld + n); v[h][0] = x[0]; v[h][1] = x[1]; v[h][2] = x[2]; v[h][3] = x[3]; }
                else { const u32x2 x = *(const u32x2*)((const bf16_t*)src + (size_t)k * ld + n); v[h][0] = bf2f((bf16_t)(x.x & 0xffff)); v[h][1] = bf2f((bf16_t)(x.x >> 16)); v[h][2] = bf2f((bf16_t)(x.y & 0xffff)); v[h][3] = bf2f((bf16_t)(x.y >> 16)); }
                if (bias) { v[h][0] += bias[n]; v[h][1] += bias[n + 1]; v[h][2] += bias[n + 2]; v[h][3] += bias[n + 3]; } } } };
    int id = blockIdx.x;
    if (id < ntiles) gload(id);
    while (id < ntiles) {
        const int k0 = (id / nN) * 64, n0 = (id % nN) * 64, nxt = id + (int)gridDim.x;
#pragma unroll
        for (int h = 0; h < 2; ++h)
#pragma unroll
            for (int j = 0; j < 4; ++j) tile[(r + 32 * h) * 65 + 4 * c4 + j] = v[h][j];
        if (nxt < ntiles) gload(nxt);
        __syncthreads();
        const int nn = tid >> 3, kc = tid & 7; const LAS float* s = tile + (8 * kc) * 65 + nn;
        u32x4 o; o.x = cvt_pk_bf16(s[0], s[65]); o.y = cvt_pk_bf16(s[2 * 65], s[3 * 65]); o.z = cvt_pk_bf16(s[4 * 65], s[5 * 65]); o.w = cvt_pk_bf16(s[6 * 65], s[7 * 65]);
        *(u32x4*)(dst + (size_t)(n0 + nn) * dld + k0 + 8 * kc) = o;
        __syncthreads();
        id = nxt;
    }
}
__device__ __forceinline__ void rmsnorm_rows(const float* X, const float* g, bf16_t* out, int rows) {
    const int lane = threadIdx.x & 63, gw = blockIdx.x * 8 + (threadIdx.x >> 6), NGW = gridDim.x * 8;
    for (int row = gw; row < rows; row += NGW) {
        const f32x4* xr = (const f32x4*)(X + (size_t)row * DM) + lane; f32x4 v[8]; float s = 0.f;
#pragma unroll
        for (int j = 0; j < 8; ++j) { v[j] = xr[64 * j]; s += (v[j][0] * v[j][0] + v[j][1] * v[j][1]) + (v[j][2] * v[j][2] + v[j][3] * v[j][3]); }
        const float rinv = rsqrtf(wave_sum(s) * (1.0f / DM) + 1e-6f);
#pragma unroll
        for (int j = 0; j < 8; ++j) { const f32x4 gv = ((const f32x4*)g)[lane + 64 * j]; u32x2 o; o.x = cvt_pk_bf16(v[j][0] * rinv * gv[0], v[j][1] * rinv * gv[1]); o.y = cvt_pk_bf16(v[j][2] * rinv * gv[2], v[j][3] * rinv * gv[3]);
            *(u32x2*)(out + (size_t)row * DM + 4 * (lane + 64 * j)) = o; }
    }
}
#define XB_TMO      128
#define XB_XCNT(j)  (256  + 64 * (j))
#define XB_XSUB(j)  (1280 + 64 * (j))
#define XB_XGEN(j)  (2304 + 64 * (j))
#define XB_TOP      3328
#define XB_TOPGEN   3392
#define XCD_BAR_WORDS 3456
#define XB_SPIN_CAP (1u << 18)

__device__ __forceinline__ unsigned xb_ld(unsigned* p)              { return __hip_atomic_load(p, __ATOMIC_RELAXED, __HIP_MEMORY_SCOPE_AGENT); }
__device__ __forceinline__ unsigned xb_add(unsigned* p, unsigned v) { return __hip_atomic_fetch_add(p, v, __ATOMIC_RELAXED, __HIP_MEMORY_SCOPE_AGENT); }
__device__ __forceinline__ unsigned xb_xcc_id() { return (unsigned)__builtin_amdgcn_s_getreg((3 << 11) | 20) & 0xFu; }
#define XB_SPIN(cond, bar) do { unsigned _sp = 0; while (cond) { __builtin_amdgcn_s_sleep(1); \
    if ((++_sp & 255u) == 0u) { if (xb_ld(&(bar)[XB_TMO])) break; if (_sp > XB_SPIN_CAP) { atomicAdd(&(bar)[XB_TMO], 1u); break; } } } } while (0)

struct XcdBarrier {
    unsigned* bar; unsigned x;
    volatile LAS unsigned* st;
};

__device__ __forceinline__ XcdBarrier xcd_barrier_post(unsigned* bar, volatile LAS unsigned* st) {
    XcdBarrier b; b.bar = bar; b.x = xb_xcc_id(); b.st = st;
    if (threadIdx.x == 0) (void)xb_add(&bar[XB_XCNT(b.x)], 1u);
    return b;
}
__device__ __forceinline__ void xcd_barrier_complete(unsigned* bar, unsigned x, unsigned& nloc, unsigned& nx) {
    const unsigned G = gridDim.x * gridDim.y * gridDim.z;
    unsigned sum, cnt, mine, sp = 0u;
    for (;;) {
        sum = 0u; cnt = 0u; mine = 0u;
#pragma unroll
        for (unsigned j = 0; j < 16; ++j) { const unsigned c = xb_ld(&bar[XB_XCNT(j)]); sum += c; cnt += (c > 0u) ? 1u : 0u; mine = (j == x) ? c : mine; }
        if (sum == G) break;
        __builtin_amdgcn_s_sleep(1);
        if ((++sp & 255u) == 0u) { if (xb_ld(&bar[XB_TMO])) break; if (sp > XB_SPIN_CAP) { atomicAdd(&bar[XB_TMO], 1u); break; } }
    }
    nloc = mine > 0u ? mine : 1u; nx = cnt > 0u ? cnt : 1u;
}

__device__ __forceinline__ void xcd_barrier(const XcdBarrier& b) {
    asm volatile("s_waitcnt vmcnt(0)" ::: "memory");
    __syncthreads();
    if (threadIdx.x == 0) {
        unsigned* bar = b.bar;
        __builtin_amdgcn_s_waitcnt(0);
        unsigned nloc = b.st[0], nx = b.st[1];
        if (nloc == 0u) { xcd_barrier_complete(bar, b.x, nloc, nx); b.st[0] = nloc; b.st[1] = nx; }
        const unsigned old = xb_add(&bar[XB_XSUB(b.x)], 1u);
        const unsigned gen = old / nloc;
        if (old + 1u == (gen + 1u) * nloc) {
            __builtin_amdgcn_fence(__ATOMIC_RELEASE, "agent");
            asm volatile("s_waitcnt vmcnt(0)" ::: "memory");
            const unsigned og = xb_add(&bar[XB_TOP], 1u);
            const unsigned tg = og / nx;
            if (og + 1u == (tg + 1u) * nx) xb_add(&bar[XB_TOPGEN], 1u);
            else XB_SPIN(xb_ld(&bar[XB_TOPGEN]) == tg, bar);
            __builtin_amdgcn_fence(__ATOMIC_ACQUIRE, "agent");
            xb_add(&bar[XB_XGEN(b.x)], 1u);
            asm volatile("s_waitcnt vmcnt(0)" ::: "memory");
        } else {
            XB_SPIN(xb_ld(&bar[XB_XGEN(b.x)]) == gen, bar);
            __builtin_amdgcn_fence(__ATOMIC_ACQUIRE, "agent");
            asm volatile("s_waitcnt vmcnt(0)" ::: "memory");
        }
    }
    __syncthreads();
}

__device__ __forceinline__ void phase_prep0(const Params& p, LAS unsigned char* lds) {
    unsigned char* ws = p.ws; LAS float* tile = (LAS float*)lds; const int tid = threadIdx.x;
    if (blockIdx.x == gridDim.x - 1) {
        float* sm = (float*)(ws + WS_SMALL);
        if (tid < 256) { const int w = tid >> 7, e = tid & 127; const float* pe = p.in[9] + w * 4096; const float* cw = p.in[8] + (size_t)w * 4096 * 128 + e; float s = 0.f;
#pragma unroll 8
            for (int i = 0; i < 4096; ++i) s += pe[i] * cw[(size_t)i * 128];
            sm[tid] = s; }
        if (tid == 256) { const float* g = p.in[7]; float mx[4];
            for (int a = 0; a < 4; ++a) { float m = 0.f; for (int i = 0; i < 128; ++i) m = fmaxf(m, fabsf(g[a * 128 + i])); mx[a] = m; }
            for (int a = 0; a < 3; ++a) sm[256 + a] = 11.3137085f * mx[0] * mx[1 + a] * 1.0002f + 0.01f; }
        if (tid == 257) { unsigned* ctl = (unsigned*)(ws + WS_SMALL + 2048); ctl[0] = 0u; }
        { unsigned* bw = (unsigned*)(ws + WS_SMALL + 4096); for (int i = tid; i < XCD_BAR_WORDS; i += 512) bw[i] = 0u; }
    }
    tconv<float>(p.in[5], 6104, 2048, 6104, 6144, (bf16_t*)(ws + WS_WIN), 2048, nullptr, -1, tile);
    tconv<float>(p.in[6], 2048, 2048, 2048, 2048, (bf16_t*)(ws + WS_WOUT), 2048, nullptr, -1, tile);
    tconv<float>(p.in[3], 8192, 2048, 8192, 8192, (bf16_t*)(ws + WS_W1), 2048, nullptr, -1, tile);
    tconv<float>(p.in[4], 2048, 8192, 2048, 2048, (bf16_t*)(ws + WS_W2), 8192, nullptr, -1, tile);
    tconv<float>(p.in[8], 128, 4096, 128, 128, (bf16_t*)(ws + WS_CMPW), 4096, nullptr, -1, tile);
    tconv<float>(p.in[8] + (size_t)4096 * 128, 128, 4096, 128, 128, (bf16_t*)(ws + WS_CMPW) + (size_t)128 * 4096, 4096, nullptr, -1, tile);
    { bf16_t* LT = (bf16_t*)(ws + WS_LORA); const float *w2 = p.in[12], *a2 = p.in[14], *g2 = p.in[15];
      for (int idx = blockIdx.x * 512 + tid; idx < 3072 * 512; idx += gridDim.x * 512) { const int n = idx >> 9, k = idx & 511; float v = 0.f;
          if (n < 1024) { if (k < 96) v = w2[k * 1024 + n]; }
          else if (n < 2048) { if (k >= 128 && k < 224) v = a2[(k - 128) * 1024 + n - 1024]; }
          else { if (k >= 256) v = g2[(k - 256) * 1024 + n - 2048]; }
          LT[idx] = f2bf(v); } }
    rmsnorm_rows(p.in[0], p.in[1], (bf16_t*)(ws + WS_HB), S);
}
__device__ __forceinline__ void phase_prep1(const Params& p, LAS unsigned char* lds) {
    unsigned char* ws = p.ws; LAS float* tile = (LAS float*)lds; const int tid = threadIdx.x;
    tconv<float>(p.in[21], 6144, 2048, 6144, 6144, (bf16_t*)(ws + WS_WIN), 2048, nullptr, -1, tile);
    tconv<float>(p.in[22], 2048, 2048, 2048, 2048, (bf16_t*)(ws + WS_WOUT), 2048, nullptr, -1, tile);
    tconv<float>(p.in[3] + (size_t)2048 * 8192, 8192, 2048, 8192, 8192, (bf16_t*)(ws + WS_W1), 2048, nullptr, -1, tile);
    tconv<float>(p.in[4] + (size_t)2048 * 8192, 2048, 8192, 2048, 2048, (bf16_t*)(ws + WS_W2), 8192, nullptr, -1, tile);
    { bf16_t* GT_ = (bf16_t*)(ws + WS_LRUG); const float *wa = p.in[25], *wx = p.in[27];
      for (int idx = blockIdx.x * 512 + tid; idx < 2048 * 1024; idx += gridDim.x * 512) { const int n = idx >> 10, k = idx & 1023, ch = n >> 1, blk = ch >> 7, d = ch & 127; float v = 0.f;
          if ((k >> 7) == blk) v = ((n & 1) ? wx : wa)[(blk * 128 + (k & 127)) * 128 + d];
          GT_[idx] = f2bf(v); } }
    rmsnorm_rows((const float*)(ws + WS_X2), p.in[1] + DM, (bf16_t*)(ws + WS_HB), S);
}

__device__ __forceinline__ void up4(u32x2 v, float (&o)[4]) { o[0] = bf2f((bf16_t)(v.x & 0xffff)); o[1] = bf2f((bf16_t)(v.x >> 16)); o[2] = bf2f((bf16_t)(v.y & 0xffff)); o[3] = bf2f((bf16_t)(v.y >> 16)); }
__device__ __forceinline__ void norm_rope16(const bf16_t* src, bf16_t* dst, const float (&ga)[4], const float (&gb)[4], const float (&cs)[4], const float (&sn)[4], int li) {
    float x1[4], x2[4]; up4(*(const u32x2*)(src + 4 * li), x1); up4(*(const u32x2*)(src + 64 + 4 * li), x2);
    float ss = 0.f;
#pragma unroll
    for (int i = 0; i < 4; ++i) ss += x1[i] * x1[i] + x2[i] * x2[i];
    const float rinv = rsqrtf(row16_sum(ss) * (1.0f / 128.f) + 1e-6f);
    float o1[4], o2[4];
#pragma unroll
    for (int i = 0; i < 4; ++i) { const float y1 = x1[i] * rinv * ga[i], y2 = x2[i] * rinv * gb[i]; o1[i] = y1 * cs[i] - y2 * sn[i]; o2[i] = y1 * sn[i] + y2 * cs[i]; }
    u32x2 w1, w2; w1.x = cvt_pk_bf16(o1[0], o1[1]); w1.y = cvt_pk_bf16(o1[2], o1[3]); w2.x = cvt_pk_bf16(o2[0], o2[1]); w2.y = cvt_pk_bf16(o2[2], o2[3]);
    *(u32x2*)(dst + 4 * li) = w1; *(u32x2*)(dst + 64 + 4 * li) = w2;
}
__device__ __forceinline__ void phase_tok0(const Params& p, LAS unsigned char* lds) {
    unsigned char* ws = p.ws; const int lane = threadIdx.x & 63, gw = blockIdx.x * 8 + (threadIdx.x >> 6), NGW = gridDim.x * 8, li = lane & 15, R = lane >> 4;
    const bf16_t* U = (const bf16_t*)(ws + WS_U);
    bf16_t *QB = (bf16_t*)(ws + WS_QB), *KSB = (bf16_t*)(ws + WS_KSB), *KWB = (bf16_t*)(ws + WS_KWB), *KCVC = (bf16_t*)(ws + WS_KCVC), *AL = (bf16_t*)(ws + WS_ALORA);
    float* GT = (float*)(ws + WS_GT);
    const float* gain = p.in[7]; const float* mu = p.in[10];
    float g0a[4], g0b[4], gka[4], gkb[4], invf[4];
#pragma unroll
    for (int i = 0; i < 4; ++i) { g0a[i] = gain[4 * li + i]; g0b[i] = gain[64 + 4 * li + i]; const int gk = (R < 2 ? 256 : 384); gka[i] = gain[gk + 4 * li + i]; gkb[i] = gain[gk + 64 + 4 * li + i];
        invf[i] = powf(10000.0f, -((float)(2 * (4 * li + i)) / 128.0f)); }
    for (int t = gw; t < S; t += NGW) {
        const bf16_t* u = U + (size_t)t * UC;
        float sn[4], cs[4];
#pragma unroll
        for (int i = 0; i < 4; ++i) sincosf((float)t * invf[i], &sn[i], &cs[i]);
        norm_rope16(u + R * 128, QB + ((size_t)t * 8 + R) * 128, g0a, g0b, cs, sn, li);
        norm_rope16(u + (4 + R) * 128, QB + ((size_t)t * 8 + 4 + R) * 128, g0a, g0b, cs, sn, li);
        { const int g = R & 1; const bf16_t* src = u + (R < 2 ? 1536 : 2048) + g * 128; bf16_t* dst = (R < 2 ? KSB : KWB) + ((size_t)g * S + t) * 128; norm_rope16(src, dst, gka, gkb, cs, sn, li); }
        { bf16_t* kv = KCVC + ((size_t)R * S + t) * 128;
          *(u32x2*)(kv + 4 * li) = *(const u32x2*)(u + 1024 + R * 128 + 4 * li); *(u32x2*)(kv + 64 + 4 * li) = *(const u32x2*)(u + 1024 + R * 128 + 64 + 4 * li); }
        if (lane < 24) GT[(size_t)t * 24 + lane] = sigm(bf2f(u[2560 + lane]));
        bf16_t* al = AL + (size_t)t * 512;
#pragma unroll
        for (int i = 0; i < 2; ++i) { const int c4 = lane + 64 * i;
            if (c4 < 112) { const int c = 3072 + 4 * c4, col = 2584 + c; float cur[4], prev[4] = {0.f, 0.f, 0.f, 0.f}, o[4]; up4(*(const u32x2*)(u + col), cur); if (t > 0) up4(*(const u32x2*)(u + col - UC), prev);
                const f32x4 m4 = *(const f32x4*)(mu + c);
#pragma unroll
                for (int e = 0; e < 4; ++e) { const float xm = cur[e] + (prev[e] - cur[e]) * m4[e]; o[e] = c < 3168 ? tanhf(xm) : (c < 3264 ? xm : sigm(xm)); }
                const int dst = c < 3168 ? c - 3072 : (c < 3264 ? 128 + c - 3168 : 256 + c - 3264);
                u32x2 w; w.x = cvt_pk_bf16(o[0], o[1]); w.y = cvt_pk_bf16(o[2], o[3]); *(u32x2*)(al + dst) = w; } }
        if (lane < 16) { const u32x2 z = {0u, 0u}; *(u32x2*)(al + (lane < 8 ? 96 : 224 - 32) + 4 * lane) = z; }
    }
    LAS float* tile = (LAS float*)lds;
    tconv<bf16_t>(U + 1792, UC, S, 256, 256, (bf16_t*)(ws + WS_VST), S, nullptr, -1, tile);
    tconv<bf16_t>(U + 2304, UC, S, 256, 256, (bf16_t*)(ws + WS_VWT), S, nullptr, -1, tile);
}
__device__ __forceinline__ void phase_cmpfin(const Params& p, LAS unsigned char* lds) {
    unsigned char* ws = p.ws; const int lane = threadIdx.x & 63, gw = blockIdx.x * 8 + (threadIdx.x >> 6), NGW = gridDim.x * 8;
    const float* C = (const float*)(ws + WS_CMPC); const float* cb = (const float*)(ws + WS_SMALL); bf16_t* KCB = (bf16_t*)(ws + WS_KCB);
    const float* gain = p.in[7]; const float g1a = gain[128 + lane], g1b = gain[192 + lane];
    const float invf = powf(10000.0f, -((float)(2 * lane) / 128.0f));
    for (int row = gw; row < 2048; row += NGW) { const int n = row & 1023; bf16_t* dst = KCB + (size_t)row * 128;
        if (n == 1023) { dst[lane] = 0; dst[64 + lane] = 0; continue; }
        const float x1 = C[(size_t)row * 256 + lane] + cb[lane], x2 = C[(size_t)row * 256 + 64 + lane] + cb[64 + lane];
        const float rinv = rsqrtf(wave_sum(x1 * x1 + x2 * x2) * (1.0f / 128.f) + 1e-6f);
        const float y1 = x1 * rinv * g1a, y2 = x2 * rinv * g1b; float sn, cs; sincosf((float)(16 * n + 31) * invf, &sn, &cs);
        dst[lane] = f2bf(y1 * cs - y2 * sn); dst[64 + lane] = f2bf(y1 * sn + y2 * cs); }
    { bf16_t* RWX = (bf16_t*)((unsigned char*)p.out + DO_RWX); const float *w0 = p.in[11], *a0 = p.in[13];
      for (int idx = blockIdx.x * 512 + threadIdx.x; idx < S * 512; idx += gridDim.x * 512) { const int t = idx >> 9, c = (idx & 511) * 4; u32x2* pp = (u32x2*)(RWX + (size_t)t * 3072 + c); const u32x2 x = *pp; float v[4];
          v[0] = bf2f((bf16_t)(x.x & 0xffff)); v[1] = bf2f((bf16_t)(x.x >> 16)); v[2] = bf2f((bf16_t)(x.y & 0xffff)); v[3] = bf2f((bf16_t)(x.y >> 16));
          if (c < 1024) {
#pragma unroll
              for (int i = 0; i < 4; ++i) { const float w = -softplusf(-(w0[c + i] + v[i])) - 0.5f; v[i] = -expf(w); } }
          else {
#pragma unroll
              for (int i = 0; i < 4; ++i) v[i] = sigm(a0[c - 1024 + i] + v[i]); }
          u32x2 o; o.x = cvt_pk_bf16(v[0], v[1]); o.y = cvt_pk_bf16(v[2], v[3]); *pp = o; } }
    LAS float* tile = (LAS float*)lds;
    for (int g = 0; g < 2; ++g)
        tconv<float>(C + (size_t)(2048 + g * 1024) * 256 + 128, 256, 1024, 128, 128, (bf16_t*)(ws + WS_VCT) + (size_t)g * 128 * 1024, 1024, cb + 128, 1023, tile);
}
constexpr int NS_KT = 0, NS_VT = 17408, NS_IMP = 35840, NS_SEL = 69120, NS_UNI = 70144, NS_ITEM = 70176;
__device__ __forceinline__ void ns_stage(LAS unsigned char* lds, const bf16_t* Ksrc, const bf16_t* VTsrc, size_t vld, bool withV) {
    const int tid = threadIdx.x;
#pragma unroll
    for (int i = 0; i < 2; ++i) { const int id = tid + 512 * i, row = id >> 4, ch = id & 15; const u32x4 v = *(const u32x4*)(Ksrc + (size_t)row * 128 + ch * 8); *(LAS u32x4*)(lds + NS_KT + row * 272 + ch * 16) = v; }
    if (withV) {
#pragma unroll
        for (int i = 0; i < 2; ++i) { const int id = tid + 512 * i, d = id >> 3, ch = id & 7; const u32x4 v = *(const u32x4*)(VTsrc + (size_t)d * vld + ch * 8); *(LAS u32x4*)(lds + NS_VT + d * 144 + ch * 16) = v; } }
}
__device__ __forceinline__ void ns_qk(LAS unsigned char* lds, int grp, const bf16x8 (&qf)[4], int lane, f32x4& s0, f32x4& s1) {
    const int i = lane & 15, quad = lane >> 4, krow = 32 * grp + (i >> 2) * 8 + (i & 3);
    s0 = (f32x4){0.f, 0.f, 0.f, 0.f}; s1 = s0;
#pragma unroll
    for (int ks = 0; ks < 4; ++ks) {
        const bf16x8 a0 = *(const LAS bf16x8*)(lds + NS_KT + krow * 272 + (32 * ks + 8 * quad) * 2);
        const bf16x8 a1 = *(const LAS bf16x8*)(lds + NS_KT + (krow + 4) * 272 + (32 * ks + 8 * quad) * 2);
        s0 = MFMA16(a0, qf[ks], s0); s1 = MFMA16(a1, qf[ks], s1); }
}
__device__ __forceinline__ void ns_pv(LAS unsigned char* lds, int grp, const f32x4& p0, const f32x4& p1, int lane, f32x4 (&o)[8]) {
    const int i = lane & 15, quad = lane >> 4;
    union { bf16x8 v; unsigned w[4]; } pf; pf.w[0] = cvt_pk_bf16(p0[0], p0[1]); pf.w[1] = cvt_pk_bf16(p0[2], p0[3]); pf.w[2] = cvt_pk_bf16(p1[0], p1[1]); pf.w[3] = cvt_pk_bf16(p1[2], p1[3]);
#pragma unroll
    for (int dt = 0; dt < 8; ++dt) { const bf16x8 a = *(const LAS bf16x8*)(lds + NS_VT + (16 * dt + i) * 144 + (32 * grp + 8 * quad) * 2); o[dt] = MFMA16(a, pf.v, o[dt]); }
}
__device__ __forceinline__ void nsa_item(const Params& p, LAS unsigned char* lds, int item) {
    unsigned char* ws = p.ws; const int tid = threadIdx.x, lane = tid & 63, w = tid >> 6, c = lane & 15, quad = lane >> 4, tq = c >> 2, j = c & 3;
    const int tile = 511 - (item >> 1), g = item & 1, t0 = tile * 32, t = t0 + 4 * w + tq;
    const bf16_t *QB = (const bf16_t*)(ws + WS_QB), *KSB = (const bf16_t*)(ws + WS_KSB), *KWB = (const bf16_t*)(ws + WS_KWB), *KCB = (const bf16_t*)(ws + WS_KCB);
    const bf16_t *VST = (const bf16_t*)(ws + WS_VST), *VWT = (const bf16_t*)(ws + WS_VWT), *VCT = (const bf16_t*)(ws + WS_VCT);
    const float* GT = (const float*)(ws + WS_GT); const float* sm = (const float*)(ws + WS_SMALL);
    const float sc2 = 0.08838834764831845f * 1.4426950408889634f;
    LAS float* imp = (LAS float*)(lds + NS_IMP) + w * 1040; LAS unsigned* sel = (LAS unsigned*)(lds + NS_SEL) + w * 32; LAS unsigned* uni = (LAS unsigned*)(lds + NS_UNI);
    bf16x8 qf[4];
#pragma unroll
    for (int ks = 0; ks < 4; ++ks) qf[ks] = *(const bf16x8*)(QB + ((size_t)t * 8 + 4 * g + j) * 128 + 32 * ks + 8 * quad);
    f32x4 otot[8], ob[8];
#pragma unroll
    for (int dt = 0; dt < 8; ++dt) { otot[dt] = (f32x4){0.f, 0.f, 0.f, 0.f}; ob[dt] = otot[dt]; }
    for (int i = lane; i < 1040; i += 64) imp[i] = 0.f;
    if (tid < 8) uni[tid] = 0u;
    {
        const float cb2 = sm[256] * 1.4426950408889634f; const int ncb = (t0 >> 4) / 64 + 1; float l = 0.f, linv = 0.f;
        for (int pass = 0; pass < 2; ++pass) {
            for (int blk = 0; blk < ncb; ++blk) {
                __syncthreads();
                ns_stage(lds, KCB + ((size_t)g * 1024 + 64 * blk) * 128, VCT + (size_t)g * 128 * 1024 + 64 * blk, 1024, pass == 1);
                __syncthreads();
#pragma unroll 1
                for (int grp = 0; grp < 2; ++grp) {
                    f32x4 s0, s1; ns_qk(lds, grp, qf, lane, s0, s1);
                    const int nb = 64 * blk + 32 * grp + 8 * quad;
#pragma unroll
                    for (int r = 0; r < 4; ++r) { s0[r] = (16 * (nb + r) + 31 <= t) ? __builtin_amdgcn_exp2f(s0[r] * sc2 - cb2) : 0.f; s1[r] = (16 * (nb + 4 + r) + 31 <= t) ? __builtin_amdgcn_exp2f(s1[r] * sc2 - cb2) : 0.f; }
                    if (pass == 0) { l += (s0[0] + s0[1]) + (s0[2] + s0[3]) + (s1[0] + s1[1]) + (s1[2] + s1[3]); }
                    else {
                        s0 *= linv; s1 *= linv;
                        float m0 = s0[0] + s0[1] + s0[2] + 0.5f * s0[3], n0 = 0.5f * s0[3], m1 = s1[0] + s1[1] + s1[2] + 0.5f * s1[3], n1 = 0.5f * s1[3];
                        m0 += __shfl_xor(m0, 1); m0 += __shfl_xor(m0, 2); n0 += __shfl_xor(n0, 1); n0 += __shfl_xor(n0, 2);
                        m1 += __shfl_xor(m1, 1); m1 += __shfl_xor(m1, 2); n1 += __shfl_xor(n1, 1); n1 += __shfl_xor(n1, 2);
                        if (j == 0) { const int m = nb >> 2; LAS float* ip = imp + tq * 260 + m; atomicAdd((float*)ip, m0); atomicAdd((float*)(ip + 1), n0 + m1); atomicAdd((float*)(ip + 2), n1); }
                        ns_pv(lds, grp, s0, s1, lane, ob);
                    }
                }
            }
            if (pass == 0) { l += __shfl_xor(l, 16); l += __shfl_xor(l, 32); linv = l > 0.f ? 1.0f / l : 0.f; }
        }
        const float gc = GT[(size_t)t * 24 + 4 * g + j];
#pragma unroll
        for (int dt = 0; dt < 8; ++dt) { otot[dt] += ob[dt] * gc; ob[dt] = (f32x4){0.f, 0.f, 0.f, 0.f}; }
    }
    __syncthreads();
    {
        const int R = lane >> 4, li = lane & 15, cur = (t0 + 4 * w + R) >> 6; LAS unsigned* selw = sel + R * 8;
        if (li < 8) selw[li] = 0u;
        if (cur < 16) { if (li == 0) selw[0] = (2u << cur) - 1u; }
        else {
            unsigned key[16];
#pragma unroll
            for (int i = 0; i < 16; ++i) { const int m = li + 16 * i; const float v = imp[R * 260 + m]; key[i] = (m >= 1 && m <= cur - 2) ? ((__float_as_uint(v) & 0xFFFFFF00u) | (unsigned)(255 - m)) : 0u; }
            for (int round = 0; round < 13; ++round) {
                unsigned bk = key[0];
#pragma unroll
                for (int i = 1; i < 16; ++i) bk = bk > key[i] ? bk : key[i];
#pragma unroll
                for (int o = 1; o < 16; o <<= 1) { const unsigned ok = (unsigned)__shfl_xor((int)bk, o); bk = bk > ok ? bk : ok; }
#pragma unroll
                for (int i = 0; i < 16; ++i) key[i] = key[i] == bk ? 0u : key[i];
                const int ms = 255 - (int)(bk & 255u);
                if (li == 0) selw[ms >> 5] |= 1u << (ms & 31);
            }
            if (li == 0) { selw[0] |= 1u; selw[cur >> 5] |= 1u << (cur & 31); selw[(cur - 1) >> 5] |= 1u << ((cur - 1) & 31); }
        }
    }
    __syncthreads();
    if (lane < 32) atomicOr((unsigned*)(uni + (lane & 7)), sel[lane]);
    __syncthreads();
    {
        const float cb2 = sm[257] * 1.4426950408889634f; const int ncur = (t0 + 31) >> 6; float l = 0.f;
        for (int m = 0; m <= ncur; ++m) {
            if (!((uni[m >> 5] >> (m & 31)) & 1u)) continue;
            __syncthreads();
            ns_stage(lds, KSB + ((size_t)g * S + 64 * m) * 128, VST + (size_t)g * 128 * S + 64 * m, S, true);
            __syncthreads();
            const bool mybit = (sel[tq * 8 + (m >> 5)] >> (m & 31)) & 1u;
            if (!__any(mybit)) continue;
#pragma unroll 1
            for (int grp = 0; grp < 2; ++grp) {
                f32x4 s0, s1; ns_qk(lds, grp, qf, lane, s0, s1);
                const int kb = 64 * m + 32 * grp + 8 * quad;
#pragma unroll
                for (int r = 0; r < 4; ++r) { s0[r] = (mybit && kb + r <= t) ? __builtin_amdgcn_exp2f(s0[r] * sc2 - cb2) : 0.f; s1[r] = (mybit && kb + 4 + r <= t) ? __builtin_amdgcn_exp2f(s1[r] * sc2 - cb2) : 0.f; }
                l += (s0[0] + s0[1]) + (s0[2] + s0[3]) + (s1[0] + s1[1]) + (s1[2] + s1[3]);
                ns_pv(lds, grp, s0, s1, lane, ob);
            }
        }
        l += __shfl_xor(l, 16); l += __shfl_xor(l, 32);
        const float gs = GT[(size_t)t * 24 + 8 + 4 * g + j] / l;
#pragma unroll
        for (int dt = 0; dt < 8; ++dt) { otot[dt] += ob[dt] * gs; ob[dt] = (f32x4){0.f, 0.f, 0.f, 0.f}; }
    }
    {
        const float cb2 = sm[258] * 1.4426950408889634f; const int mb0 = (t0 >= 511 ? (t0 - 511) : 0) >> 6, mb1 = t0 >> 6; float l = 0.f;
        for (int m = mb0; m <= mb1; ++m) {
            __syncthreads();
            ns_stage(lds, KWB + ((size_t)g * S + 64 * m) * 128, VWT + (size_t)g * 128 * S + 64 * m, S, true);
            __syncthreads();
#pragma unroll 1
            for (int grp = 0; grp < 2; ++grp) {
                f32x4 s0, s1; ns_qk(lds, grp, qf, lane, s0, s1);
                const int kb = 64 * m + 32 * grp + 8 * quad;
#pragma unroll
                for (int r = 0; r < 4; ++r) { const int d0 = t - (kb + r), d1 = t - (kb + 4 + r);
                    s0[r] = (d0 >= 0 && d0 < 512) ? __builtin_amdgcn_exp2f(s0[r] * sc2 - cb2) : 0.f; s1[r] = (d1 >= 0 && d1 < 512) ? __builtin_amdgcn_exp2f(s1[r] * sc2 - cb2) : 0.f; }
                l += (s0[0] + s0[1]) + (s0[2] + s0[3]) + (s1[0] + s1[1]) + (s1[2] + s1[3]);
                ns_pv(lds, grp, s0, s1, lane, ob);
            }
        }
        l += __shfl_xor(l, 16); l += __shfl_xor(l, 32);
        const float gw_ = GT[(size_t)t * 24 + 16 + 4 * g + j] / l;
#pragma unroll
        for (int dt = 0; dt < 8; ++dt) otot[dt] += ob[dt] * gw_;
    }
    bf16_t* Y = (bf16_t*)(ws + WS_HB) + (size_t)t * DM + 512 * g + 128 * j + 4 * quad;
#pragma unroll
    for (int dt = 0; dt < 8; ++dt) { u32x2 o; o.x = cvt_pk_bf16(otot[dt][0], otot[dt][1]); o.y = cvt_pk_bf16(otot[dt][2], otot[dt][3]); *(u32x2*)(Y + 16 * dt) = o; }
    __syncthreads();
}

typedef float f32x2v __attribute__((ext_vector_type(2)));
constexpr int NSCAN = 64;
__device__ __forceinline__ void rwkv_scan(const Params& p, LAS unsigned char* lds) {
    unsigned char* ws = p.ws; const int tid = threadIdx.x, lane = tid & 63, w = tid >> 6;
    const int h = blockIdx.x >> 2, qr = blockIdx.x & 3;
    const bf16_t* U = (const bf16_t*)(ws + WS_U); const bf16_t* RWX = (const bf16_t*)((unsigned char*)p.out + DO_RWX);
    bf16_t* YB = (bf16_t*)(ws + WS_YB);
    LAS float* ybuf = (LAS float*)(lds + 98304);
    if (w >= 4) {
        const int pt = tid - 256, j0 = 4 * (pt & 15);
        float kkw[4], kaw[4], mur[4], muk[4], muv[4];
#pragma unroll
        for (int i = 0; i < 4; ++i) { kkw[i] = p.in[16][h * 64 + j0 + i]; kaw[i] = p.in[17][h * 64 + j0 + i]; mur[i] = p.in[10][h * 64 + j0 + i]; muk[i] = p.in[10][1024 + h * 64 + j0 + i]; muv[i] = p.in[10][2048 + h * 64 + j0 + i]; }
        auto unpack = [&](u32x2 v, float (&o)[4]) { o[0] = bf2f((bf16_t)(v.x & 0xffff)); o[1] = bf2f((bf16_t)(v.x >> 16)); o[2] = bf2f((bf16_t)(v.y & 0xffff)); o[3] = bf2f((bf16_t)(v.y >> 16)); };
        struct Raw { u32x2 rc, kc, vc, rp, kp, vp, lw, aa; };
        auto gload = [&](Raw& q, int chunk, int hs) { const int ss = (pt >> 4) + 16 * hs, t = 32 * chunk + ss;
            const bf16_t* u = U + (size_t)t * UC + 2584 + h * 64 + j0; const u32x2 z = {0u, 0u};
            q.rc = *(const u32x2*)u; q.kc = *(const u32x2*)(u + 1024); q.vc = *(const u32x2*)(u + 2048);
            q.rp = z; q.kp = z; q.vp = z; if (t > 0) { q.rp = *(const u32x2*)(u - UC); q.kp = *(const u32x2*)(u - UC + 1024); q.vp = *(const u32x2*)(u - UC + 2048); }
            q.lw = *(const u32x2*)(RWX + (size_t)t * 3072 + h * 64 + j0); q.aa = *(const u32x2*)(RWX + (size_t)t * 3072 + 1024 + h * 64 + j0); };
        auto stage = [&](const Raw& q, int chunk, int hs) { const int ss = (pt >> 4) + 16 * hs;
            float a[4], b[4], r[4], k[4], v[4], lwf[4], aaf[4];
            unpack(q.rc, a); unpack(q.rp, b);
#pragma unroll
            for (int i = 0; i < 4; ++i) r[i] = a[i] + (b[i] - a[i]) * mur[i];
            unpack(q.kc, a); unpack(q.kp, b);
#pragma unroll
            for (int i = 0; i < 4; ++i) k[i] = a[i] + (b[i] - a[i]) * muk[i];
            unpack(q.vc, a); unpack(q.vp, b);
#pragma unroll
            for (int i = 0; i < 4; ++i) v[i] = a[i] + (b[i] - a[i]) * muv[i];
            unpack(q.lw, lwf); unpack(q.aa, aaf);
            float kk[4], sq = 0.f;
#pragma unroll
            for (int i = 0; i < 4; ++i) { kk[i] = k[i] * kkw[i]; sq += kk[i] * kk[i]; }
            sq = row16_sum(sq); const float kn = __builtin_amdgcn_rsqf(fmaxf(sq, 1e-24f));
            f32x4 W_, A_, B_, K_, R_, V_;
#pragma unroll
            for (int i = 0; i < 4; ++i) { const float kki = kk[i] * kn; W_[i] = __expf(lwf[i]); A_[i] = -kki; B_[i] = kki * aaf[i]; K_[i] = k[i] * (1.0f + (aaf[i] - 1.0f) * kaw[i]); R_[i] = r[i]; V_[i] = v[i]; }
            LAS unsigned char* bp = lds + (chunk & 1) * 49152 + (ss * 64 + j0) * 4;
            *(LAS f32x4*)(bp) = W_; *(LAS f32x4*)(bp + 8192) = A_; *(LAS f32x4*)(bp + 16384) = B_; *(LAS f32x4*)(bp + 24576) = K_; *(LAS f32x4*)(bp + 32768) = R_; *(LAS f32x4*)(bp + 40960) = V_; };
        Raw c0, c1, n0, n1;
        gload(c0, 0, 0); gload(c1, 0, 1);
        for (int chunk = -1; chunk < 512; ++chunk) {
            if (chunk + 2 < 512) { gload(n0, chunk + 2, 0); gload(n1, chunk + 2, 1); }
            if (chunk + 1 < 512) { stage(c0, chunk + 1, 0); stage(c1, chunk + 1, 1); }
            if (chunk >= 1) { const int cc = chunk - 1, ss = pt >> 3, pr = pt & 7; const LAS float* yb = ybuf + (cc & 1) * 512 + ss * 16 + 2 * pr;
                *(unsigned*)(YB + (size_t)(32 * cc + ss) * 1024 + h * 64 + 16 * qr + 2 * pr) = cvt_pk_bf16(yb[0], yb[1]); }
            __syncthreads();
            c0 = n0; c1 = n1;
        }
        { const int c1 = 511, ss = pt >> 3, pr = pt & 7; const LAS float* yb = ybuf + (c1 & 1) * 512 + ss * 16 + 2 * pr;
          *(unsigned*)(YB + (size_t)(32 * c1 + ss) * 1024 + h * 64 + 16 * qr + 2 * pr) = cvt_pk_bf16(yb[0], yb[1]); }
    } else {
        const int iloc = 4 * w + (lane >> 4), irow = 16 * qr + iloc, jj = 4 * (lane & 15);
        f32x2v S01 = {0.f, 0.f}, S23 = {0.f, 0.f};
        __syncthreads();
        for (int chunk = 0; chunk < 512; ++chunk) {
            LAS unsigned char* bp = lds + (chunk & 1) * 49152 + jj * 4; LAS float* vb = (LAS float*)(lds + (chunk & 1) * 49152 + 40960) + irow; LAS float* yb = ybuf + (chunk & 1) * 512 + iloc;
            struct Ops { f32x4 W[4], A[4], B[4], K[4], R[4]; float v[4]; };
            Ops q0, q1;
            auto load4 = [&](Ops& q, int s0) {
#pragma unroll
                for (int i = 0; i < 4; ++i) { const int s = s0 + i; q.W[i] = *(const LAS f32x4*)(bp + s * 256); q.A[i] = *(const LAS f32x4*)(bp + 8192 + s * 256); q.B[i] = *(const LAS f32x4*)(bp + 16384 + s * 256);
                    q.K[i] = *(const LAS f32x4*)(bp + 24576 + s * 256); q.R[i] = *(const LAS f32x4*)(bp + 32768 + s * 256); q.v[i] = vb[s * 64]; } };
            auto comp4 = [&](const Ops& q, int s0) {
                float yp[4];
#pragma unroll
                for (int i = 0; i < 4; ++i) {
                    const f32x4 W_ = q.W[i], A_ = q.A[i], B_ = q.B[i], K_ = q.K[i], R_ = q.R[i]; const float v = q.v[i];
                    const f32x2v vv = {v, v};
                    const f32x2v d = S01 * (f32x2v){A_[0], A_[1]} + S23 * (f32x2v){A_[2], A_[3]};
                    const f32x2v t01 = S01 * (f32x2v){W_[0], W_[1]} + vv * (f32x2v){K_[0], K_[1]}, t23 = S23 * (f32x2v){W_[2], W_[3]} + vv * (f32x2v){K_[2], K_[3]};
                    const float sa = row16_sum(d.x + d.y); const f32x2v sav = {sa, sa};
                    S01 = sav * (f32x2v){B_[0], B_[1]} + t01;
                    S23 = sav * (f32x2v){B_[2], B_[3]} + t23;
                    const f32x2v yd = S01 * (f32x2v){R_[0], R_[1]} + S23 * (f32x2v){R_[2], R_[3]};
                    yp[i] = yd.x + yd.y;
                }
#pragma unroll
                for (int i = 0; i < 4; ++i) yp[i] = row16_sum(yp[i]);
#pragma unroll
                for (int i = 0; i < 4; ++i) yb[(s0 + i) * 16] = yp[i]; };
            load4(q0, 0);
#pragma unroll 1
            for (int b2 = 0; b2 < 4; ++b2) {
                load4(q1, 8 * b2 + 4);
                comp4(q0, 8 * b2);
                if (b2 < 3) load4(q0, 8 * b2 + 8);
                comp4(q1, 8 * b2 + 4);
            }
            __syncthreads();
        }
    }
}
__device__ __forceinline__ void phase_mix0(const Params& p, LAS unsigned char* lds, unsigned long long& g_probe_scan) {
#ifdef PROBE_SCAN
    { const unsigned long long ts0 = wall_clock64(); if (blockIdx.x < NSCAN) rwkv_scan(p, lds); g_probe_scan = wall_clock64() - ts0; }
#else
    if (blockIdx.x < NSCAN) rwkv_scan(p, lds);
#endif
    unsigned* ctl = (unsigned*)(p.ws + WS_SMALL + 2048); LAS int* itemw = (LAS int*)(lds + NS_ITEM);
    for (;;) {
        __syncthreads();
        if (threadIdx.x == 0) *itemw = (int)atomicAdd(ctl, 1u);
        __syncthreads();
        const int item = *itemw;
        if (item >= 1024) break;
        nsa_item(p, lds, item);
    }
}
__device__ __forceinline__ void phase_rwfin(const Params& p) {
    unsigned char* ws = p.ws; const int lane = threadIdx.x & 63, gw = blockIdx.x * 8 + (threadIdx.x >> 6), NGW = gridDim.x * 8, li = lane & 15, R = lane >> 4;
    const bf16_t* U = (const bf16_t*)(ws + WS_U); const bf16_t* RWX = (const bf16_t*)((unsigned char*)p.out + DO_RWX);
    const bf16_t* YB = (const bf16_t*)(ws + WS_YB); bf16_t* Y = (bf16_t*)(ws + WS_HB);
    const float* mu = p.in[10];
    for (int it = gw; it < S * 4; it += NGW) { const int t = it >> 2, h = (it & 3) * 4 + R, cix = h * 64 + 4 * li;
        const bf16_t* u = U + (size_t)t * UC + 2584 + cix;
        float y[4]; up4(*(const u32x2*)(YB + (size_t)t * 1024 + cix), y);
        const float mean = row16_sum((y[0] + y[1]) + (y[2] + y[3])) * (1.0f / 64.f); float var = 0.f;
#pragma unroll
        for (int i = 0; i < 4; ++i) { y[i] -= mean; var += y[i] * y[i]; }
        const float rstd = rsqrtf(row16_sum(var) * (1.0f / 64.f) + 64e-5f);
        float rc[4], kc[4], vc[4], rp[4] = {0.f, 0.f, 0.f, 0.f}, kp[4] = {0.f, 0.f, 0.f, 0.f}, vp[4] = {0.f, 0.f, 0.f, 0.f}, a[4], g[4];
        up4(*(const u32x2*)u, rc); up4(*(const u32x2*)(u + 1024), kc); up4(*(const u32x2*)(u + 2048), vc);
        if (t > 0) { up4(*(const u32x2*)(u - UC), rp); up4(*(const u32x2*)(u + 1024 - UC), kp); up4(*(const u32x2*)(u + 2048 - UC), vp); }
        up4(*(const u32x2*)(RWX + (size_t)t * 3072 + 1024 + cix), a); up4(*(const u32x2*)(RWX + (size_t)t * 3072 + 2048 + cix), g);
        const f32x4 mr = *(const f32x4*)(mu + cix), mk = *(const f32x4*)(mu + 1024 + cix), mv = *(const f32x4*)(mu + 2048 + cix), ka = *(const f32x4*)(p.in[17] + cix), rk = *(const f32x4*)(p.in[18] + cix);
        const f32x4 lw = *(const f32x4*)(p.in[19] + cix), lb = *(const f32x4*)(p.in[20] + cix);
        float bsum = 0.f, v[4];
#pragma unroll
        for (int i = 0; i < 4; ++i) { const float r = rc[i] + (rp[i] - rc[i]) * mr[i], k = kc[i] + (kp[i] - kc[i]) * mk[i]; v[i] = vc[i] + (vp[i] - vc[i]) * mv[i];
            bsum += r * (k * (1.0f + (a[i] - 1.0f) * ka[i])) * rk[i]; }
        bsum = row16_sum(bsum);
        float o[4];
#pragma unroll
        for (int i = 0; i < 4; ++i) o[i] = (y[i] * rstd * lw[i] + lb[i] + bsum * v[i]) * g[i];
        u32x2 w; w.x = cvt_pk_bf16(o[0], o[1]); w.y = cvt_pk_bf16(o[2], o[3]); *(u32x2*)(Y + (size_t)t * DM + 1024 + cix) = w;
    }
}
__device__ __forceinline__ float silu_f(float x) { return x / (1.0f + expf(-x)); }
__device__ __forceinline__ float gelu_tanh(float x) { const float u = 0.7978845608028654f * (x + 0.044715f * x * x * x); return 0.5f * x * (1.0f + tanhf(u)); }
__device__ __forceinline__ void phase_conv(const Params& p) {
    unsigned char* ws = p.ws; const bf16_t* U = (const bf16_t*)(ws + WS_U); bf16_t* XCB = (bf16_t*)(ws + WS_HB);
    const float *cw = p.in[23], *cbias = p.in[24];
    for (int idx = blockIdx.x * 512 + threadIdx.x; idx < S * 256; idx += gridDim.x * 512) { const int t = idx >> 8, c = (idx & 255) * 4; float acc[4];
#pragma unroll
        for (int i = 0; i < 4; ++i) acc[i] = cbias[c + i];
#pragma unroll
        for (int w = 0; w < 4; ++w) { const int tt = t - 3 + w; if (tt < 0) continue; const u32x2 x = *(const u32x2*)(U + (size_t)tt * UC + 1024 + c);
            acc[0] += cw[w * 1024 + c] * bf2f((bf16_t)(x.x & 0xffff)); acc[1] += cw[w * 1024 + c + 1] * bf2f((bf16_t)(x.x >> 16)); acc[2] += cw[w * 1024 + c + 2] * bf2f((bf16_t)(x.y & 0xffff)); acc[3] += cw[w * 1024 + c + 3] * bf2f((bf16_t)(x.y >> 16)); }
        u32x2 o; o.x = cvt_pk_bf16(acc[0], acc[1]); o.y = cvt_pk_bf16(acc[2], acc[3]); *(u32x2*)(XCB + (size_t)t * 1024 + c) = o; }
}
__device__ __forceinline__ void lru_chunk(const Params& p, bool apply) {
    unsigned char* ws = p.ws;
    bf16_t* RG = (bf16_t*)((unsigned char*)p.out + DO_RG); const bf16_t* XCB = (const bf16_t*)(ws + WS_HB);
    float* LP = (float*)(ws + WS_LRUP); float* LH = (float*)(ws + WS_LRUH); const bf16_t* U = (const bf16_t*)(ws + WS_U); bf16_t* Y = (bf16_t*)(ws + WS_HB);
    for (int gid = blockIdx.x * 512 + threadIdx.x; gid < 256 * 512; gid += gridDim.x * 512) {
        const int c = gid >> 9, ch = (gid & 511) * 2;
        float h0 = 0.f, h1 = 0.f, sl0 = 0.f, sl1 = 0.f;
        if (apply) { h0 = LH[c * 1024 + ch]; h1 = LH[c * 1024 + ch + 1]; }
        const float ba0 = p.in[26][ch], ba1 = p.in[26][ch + 1], bx0 = p.in[28][ch], bx1 = p.in[28][ch + 1], sp0 = softplusf(-p.in[29][ch]), sp1 = softplusf(-p.in[29][ch + 1]);
#pragma unroll 4
        for (int i = 0; i < 64; ++i) { const size_t t = (size_t)c * 64 + i; u32x2* pp = (u32x2*)(RG + t * 2048 + 2 * ch); const u32x2 x = *pp;
            float la0, b0, la1, b1;
            if (!apply) { const unsigned xc2 = *(const unsigned*)(XCB + t * 1024 + ch);
                const float r0 = sigm(bf2f((bf16_t)(x.x & 0xffff)) + ba0), i0 = sigm(bf2f((bf16_t)(x.x >> 16)) + bx0), r1 = sigm(bf2f((bf16_t)(x.y & 0xffff)) + ba1), i1 = sigm(bf2f((bf16_t)(x.y >> 16)) + bx1);
                la0 = -8.f * r0 * sp0; la1 = -8.f * r1 * sp1;
                b0 = sqrtf(-expm1f(2.f * la0)) * i0 * bf2f((bf16_t)(xc2 & 0xffff)); b1 = sqrtf(-expm1f(2.f * la1)) * i1 * bf2f((bf16_t)(xc2 >> 16));
                u32x2 o; o.x = cvt_pk_bf16(la0, b0); o.y = cvt_pk_bf16(la1, b1); *pp = o;
                la0 = bf2f((bf16_t)(o.x & 0xffff)); b0 = bf2f((bf16_t)(o.x >> 16)); la1 = bf2f((bf16_t)(o.y & 0xffff)); b1 = bf2f((bf16_t)(o.y >> 16)); }
            else { la0 = bf2f((bf16_t)(x.x & 0xffff)); b0 = bf2f((bf16_t)(x.x >> 16)); la1 = bf2f((bf16_t)(x.y & 0xffff)); b1 = bf2f((bf16_t)(x.y >> 16)); }
            h0 = expf(la0) * h0 + b0; h1 = expf(la1) * h1 + b1; sl0 += la0; sl1 += la1;
            if (apply) { const unsigned gi = *(const unsigned*)(U + t * UC + ch); *(unsigned*)(Y + t * DM + ch) = cvt_pk_bf16(h0 * gelu_tanh(bf2f((bf16_t)(gi & 0xffff))), h1 * gelu_tanh(bf2f((bf16_t)(gi >> 16)))); } }
        if (!apply) { LP[c * 1024 + ch] = expf(sl0); LP[c * 1024 + ch + 1] = expf(sl1); LH[c * 1024 + ch] = h0; LH[c * 1024 + ch + 1] = h1; }
    }
}
__device__ __forceinline__ void lru_carry(const Params& p, int chn) {
    float* LP = (float*)(p.ws + WS_LRUP); float* LH = (float*)(p.ws + WS_LRUH); float carry = 0.f;
    for (int c0 = 0; c0 < 256; c0 += 8) { float pv[8], hv[8];
#pragma unroll
        for (int i = 0; i < 8; ++i) { pv[i] = LP[(c0 + i) * 1024 + chn]; hv[i] = LH[(c0 + i) * 1024 + chn]; }
#pragma unroll
        for (int i = 0; i < 8; ++i) { LH[(c0 + i) * 1024 + chn] = carry; carry = pv[i] * carry + hv[i]; } }
}
constexpr int HG_BC = 0, HG_KT = 32768, HG_VT = 51200;
constexpr int HC_QIN = 32768, HC_QI = 50176, HC_KI = 67584, HC_VT = 111104, HC_ATT = 129536, HC_RED = 138752;
__device__ __forceinline__ void hg_bcum(const Params& p, LAS unsigned char* lds, int c, int h, float lower, int k, int q4) {
    const bf16_t* U = (const bf16_t*)(p.ws + WS_U); LAS float* BC = (LAS float*)(lds + HG_BC); LAS float* TOT = (LAS float*)(lds + 138752);
    float cs[16]; bf16_t fr[16];
#pragma unroll
    for (int i = 0; i < 16; ++i) fr[i] = U[(size_t)(64 * c + q4 * 16 + i) * UC + 3072 + 128 * h + k];
    float run = 0.f;
#pragma unroll
    for (int i = 0; i < 16; ++i) { run += logf(lower + (1.0f - lower) * sigm(bf2f(fr[i]))); cs[i] = run; }
    TOT[q4 * 128 + k] = run;
    __syncthreads();
    float off = 0.f;
#pragma unroll
    for (int q = 0; q < 3; ++q) off += (q < q4) ? TOT[q * 128 + k] : 0.f;
#pragma unroll
    for (int i = 0; i < 16; ++i) BC[(q4 * 16 + i) * 128 + k] = cs[i] + off;
    __syncthreads();
}
__device__ __forceinline__ void hgrn_a(const Params& p, LAS unsigned char* lds) {
    unsigned char* ws = p.ws; const int tid = threadIdx.x, lane = tid & 63, w = tid >> 6, k = tid & 127, q4 = tid >> 7, li = lane & 15, quad = lane >> 4;
    const bf16_t* U = (const bf16_t*)(ws + WS_U); bf16_t* HGS = (bf16_t*)((unsigned char*)p.out + DO_HGS); float* HGD = (float*)(ws + WS_HGD);
    LAS float* BC = (LAS float*)(lds + HG_BC);
    for (int item = blockIdx.x; item < 2048; item += gridDim.x) { const int c = item >> 3, h = item & 7;
        const float lower = sigm(p.in[30][1024 + 128 * h + k] - p.in[30][128 * h + k]);
        hg_bcum(p, lds, c, h, lower, k, q4);
        const float blast = BC[63 * 128 + k];
#pragma unroll 8
        for (int t = q4 * 16; t < q4 * 16 + 16; ++t) { const bf16_t* u = U + (size_t)(64 * c + t) * UC + 128 * h + k;
            const float forget = lower + (1.0f - lower) * sigm(bf2f(u[3072]));
            *(LAS bf16_t*)(lds + HG_KT + (k * 72 + t) * 2) = f2bf((1.0f - forget) * expf(blast - BC[t * 128 + k]));
            *(LAS bf16_t*)(lds + HG_VT + (k * 72 + t) * 2) = u[4096]; }
        if (tid < 128) HGD[(size_t)(c * 8 + h) * 128 + k] = expf(blast);
        __syncthreads();
        bf16x8 av[2];
#pragma unroll
        for (int ks = 0; ks < 2; ++ks) av[ks] = *(const LAS bf16x8*)(lds + HG_VT + (16 * w + li) * 144 + (32 * ks + 8 * quad) * 2);
#pragma unroll
        for (int kt = 0; kt < 8; ++kt) { f32x4 acc = {0.f, 0.f, 0.f, 0.f};
#pragma unroll
            for (int ks = 0; ks < 2; ++ks) { const bf16x8 b = *(const LAS bf16x8*)(lds + HG_KT + (16 * kt + li) * 144 + (32 * ks + 8 * quad) * 2); acc = MFMA16(av[ks], b, acc); }
#pragma unroll
            for (int r = 0; r < 4; ++r) HGS[((size_t)(c * 8 + h) * 128 + 16 * w + 4 * quad + r) * 128 + 16 * kt + li] = f2bf(acc[r]); }
        __syncthreads();
    }
}
__device__ __forceinline__ void hgrn_b(const Params& p) {
    for (int e = blockIdx.x * 512 + threadIdx.x; e < 65536; e += gridDim.x * 512) {
    unsigned* HG = (unsigned*)((unsigned char*)p.out + DO_HGS); const float* HGD = (const float*)(p.ws + WS_HGD);
    const int h = e >> 13, k = (e & 63) * 2; float r0 = 0.f, r1 = 0.f;
    for (int c0 = 0; c0 < 256; c0 += 8) { unsigned lv[8]; float d0[8], d1[8];
#pragma unroll
        for (int i = 0; i < 8; ++i) { lv[i] = HG[(size_t)(c0 + i) * 65536 + e]; d0[i] = HGD[(size_t)((c0 + i) * 8 + h) * 128 + k]; d1[i] = HGD[(size_t)((c0 + i) * 8 + h) * 128 + k + 1]; }
#pragma unroll
        for (int i = 0; i < 8; ++i) { HG[(size_t)(c0 + i) * 65536 + e] = cvt_pk_bf16(r0, r1); r0 = d0[i] * r0 + bf2f((bf16_t)(lv[i] & 0xffff)); r1 = d1[i] * r1 + bf2f((bf16_t)(lv[i] >> 16)); } }
    }
}
__device__ __forceinline__ void hgrn_c(const Params& p, LAS unsigned char* lds) {
    unsigned char* ws = p.ws; const int tid = threadIdx.x, lane = tid & 63, w = tid >> 6, k = tid & 127, q4 = tid >> 7, li = lane & 15, quad = lane >> 4;
    const bf16_t* U = (const bf16_t*)(ws + WS_U); const bf16_t* HGS = (const bf16_t*)((unsigned char*)p.out + DO_HGS); bf16_t* Y = (bf16_t*)(ws + WS_HB);
    LAS float* BC = (LAS float*)(lds + HG_BC); LAS float* RED = (LAS float*)(lds + HC_RED);
    for (int item = blockIdx.x; item < 2048; item += gridDim.x) { const int c = item >> 3, h = item & 7;
        const float lower = sigm(p.in[30][1024 + 128 * h + k] - p.in[30][128 * h + k]);
        hg_bcum(p, lds, c, h, lower, k, q4);
        for (int i = tid; i < 576; i += 512) *(LAS u32x4*)(lds + HC_ATT + i * 16) = (u32x4){0u, 0u, 0u, 0u};
#pragma unroll 4
        for (int t = q4 * 16; t < q4 * 16 + 16; ++t) { const bf16_t* u = U + (size_t)(64 * c + t) * UC + 128 * h + k;
            const float bc = BC[t * 128 + k], bref = q4 > 0 ? BC[(16 * q4 - 1) * 128 + k] : 0.f;
            const float qv = silu_f(bf2f(u[2048])), kh = 1.0f - (lower + (1.0f - lower) * sigm(bf2f(u[3072])));
            *(LAS bf16_t*)(lds + HC_QIN + (t * 136 + k) * 2) = f2bf(qv * expf(bc));
            *(LAS bf16_t*)(lds + HC_QI + (t * 136 + k) * 2) = f2bf(qv * expf(bc - bref));
            *(LAS bf16_t*)(lds + HC_VT + (k * 72 + t) * 2) = u[4096];
            for (int I = q4; I < 4; ++I) { const float br = I > 0 ? BC[(16 * I - 1) * 128 + k] : 0.f; const int ro = (I == 0 ? 0 : (I == 1 ? 16 : (I == 2 ? 48 : 96)));
                *(LAS bf16_t*)(lds + HC_KI + ((ro + t) * 136 + k) * 2) = f2bf(kh * expf(fminf(br - bc, 80.f))); } }
        __syncthreads();
        for (int ti = w; ti < 10; ti += 8) {
            const int I = ti < 1 ? 0 : (ti < 3 ? 1 : (ti < 6 ? 2 : 3)), J = ti - (I == 0 ? 0 : (I == 1 ? 1 : (I == 2 ? 3 : 6))), ro = (I == 0 ? 0 : (I == 1 ? 16 : (I == 2 ? 48 : 96)));
            f32x4 acc = {0.f, 0.f, 0.f, 0.f};
#pragma unroll
            for (int ks = 0; ks < 4; ++ks) { const bf16x8 a = *(const LAS bf16x8*)(lds + HC_QI + (16 * I + li) * 272 + (32 * ks + 8 * quad) * 2), b = *(const LAS bf16x8*)(lds + HC_KI + (ro + 16 * J + li) * 272 + (32 * ks + 8 * quad) * 2); acc = MFMA16(a, b, acc); }
#pragma unroll
            for (int r = 0; r < 4; ++r) { const int t = 16 * I + 4 * quad + r, s = 16 * J + li; *(LAS bf16_t*)(lds + HC_ATT + (t * 72 + s) * 2) = f2bf(s <= t ? acc[r] : 0.f); } }
        __syncthreads();
        f32x4 o[4];
#pragma unroll
        for (int tt = 0; tt < 4; ++tt) o[tt] = (f32x4){0.f, 0.f, 0.f, 0.f};
#pragma unroll
        for (int ks = 0; ks < 4; ++ks) { const bf16x8 a = *(const bf16x8*)(HGS + ((size_t)(c * 8 + h) * 128 + 16 * w + li) * 128 + 32 * ks + 8 * quad);
#pragma unroll
            for (int tt = 0; tt < 4; ++tt) { const bf16x8 b = *(const LAS bf16x8*)(lds + HC_QIN + (16 * tt + li) * 272 + (32 * ks + 8 * quad) * 2); o[tt] = MFMA16(a, b, o[tt]); } }
#pragma unroll
        for (int ks = 0; ks < 2; ++ks) { const bf16x8 a = *(const LAS bf16x8*)(lds + HC_VT + (16 * w + li) * 144 + (32 * ks + 8 * quad) * 2);
#pragma unroll
            for (int tt = 0; tt < 4; ++tt) { const bf16x8 b = *(const LAS bf16x8*)(lds + HC_ATT + (16 * tt + li) * 144 + (32 * ks + 8 * quad) * 2); o[tt] = MFMA16(a, b, o[tt]); } }
#pragma unroll
        for (int tt = 0; tt < 4; ++tt) { float sq = (o[tt][0] * o[tt][0] + o[tt][1] * o[tt][1]) + (o[tt][2] * o[tt][2] + o[tt][3] * o[tt][3]); sq += __shfl_xor(sq, 16); sq += __shfl_xor(sq, 32); if (quad == 0) RED[w * 64 + 16 * tt + li] = sq; }
        __syncthreads();
#pragma unroll
        for (int tt = 0; tt < 4; ++tt) { float tot = 0.f;
#pragma unroll
            for (int ww = 0; ww < 8; ++ww) tot += RED[ww * 64 + 16 * tt + li];
            const float rinv = rsqrtf(tot * (1.0f / 128.f) + 1e-6f); const int t = 64 * c + 16 * tt + li, vcol = 128 * h + 16 * w + 4 * quad;
            const u32x2 gp = *(const u32x2*)(U + (size_t)t * UC + 5120 + vcol); const f32x4 ng = *(const f32x4*)(p.in[31] + vcol);
            const float g0 = bf2f((bf16_t)(gp.x & 0xffff)), g1 = bf2f((bf16_t)(gp.x >> 16)), g2 = bf2f((bf16_t)(gp.y & 0xffff)), g3 = bf2f((bf16_t)(gp.y >> 16));
            u32x2 ov; ov.x = cvt_pk_bf16(o[tt][0] * rinv * ng[0] * silu_f(g0), o[tt][1] * rinv * ng[1] * silu_f(g1)); ov.y = cvt_pk_bf16(o[tt][2] * rinv * ng[2] * silu_f(g2), o[tt][3] * rinv * ng[3] * silu_f(g3));
            *(u32x2*)(Y + (size_t)t * DM + 1024 + vcol) = ov; }
        __syncthreads();
    }
}
#ifndef MASK
#define MASK 0xFFFFFFFF
#endif
#define PH(n) (((MASK) >> (n)) & 1)
template <class T> __device__ __forceinline__ T* uni_ptr(T* ptr) { const unsigned long long v = (unsigned long long)ptr; const unsigned lo = __builtin_amdgcn_readfirstlane((unsigned)v), hi = __builtin_amdgcn_readfirstlane((unsigned)(v >> 32)); return (T*)(((unsigned long long)hi << 32) | lo); }
__global__ void __launch_bounds__(512) mk_forward(const Params kp) {
    extern __shared__ __attribute__((aligned(16))) unsigned char shm[];
    LAS unsigned char* lds = (LAS unsigned char*)shm;
    unsigned char* ws = kp.ws; unsigned char* dob = (unsigned char*)kp.out; const int lo = kp.ph_lo, hi = kp.ph_hi;
    { LAS Params* lp = (LAS Params*)(lds + LDS_BYTES - 512);
      if (threadIdx.x < 4) ((LAS unsigned*)(lds + LDS_BYTES - 512 + 320))[threadIdx.x] = 0u;
      __syncthreads();
      if (threadIdx.x == 0) {
#pragma unroll
          for (int i = 0; i < 32; ++i) lp->in[i] = kp.in[i];
          lp->out = (float*)dob; lp->ws = ws; lp->ph_lo = lo; lp->ph_hi = hi; }
      __syncthreads(); }
    const Params& p = *(const Params*)(shm + LDS_BYTES - 512);
    bf16_t *WIN = (bf16_t*)(ws + WS_WIN), *WOUT = (bf16_t*)(ws + WS_WOUT), *W1 = (bf16_t*)(ws + WS_W1), *W2 = (bf16_t*)(ws + WS_W2), *HB = (bf16_t*)(ws + WS_HB), *UB = (bf16_t*)(ws + WS_U), *ZB = (bf16_t*)(ws + WS_Z);
    float* X2 = (float*)(ws + WS_X2);
#ifdef PROBE_MASK
    unsigned long long t_prev = wall_clock64(), t_acc = 0ull;
#define PROBE_TICK(k) { const unsigned long long t_now = wall_clock64(); if ((k) > 0 && ((PROBE_MASK >> ((k) - 1)) & 1)) t_acc += t_now - t_prev; t_prev = t_now; }
#else
#define PROBE_TICK(k)
#endif
    XcdBarrier xb; xb.bar = (unsigned*)(ws + WS_SMALL + 4096); xb.x = 0u; xb.st = (volatile LAS unsigned*)(lds + LDS_BYTES - 512 + 320);
    bool posted = false;
#define SEAM(k) { if (!posted) { cg::this_grid().sync(); xb = xcd_barrier_post((unsigned*)(ws + WS_SMALL + 4096), (volatile LAS unsigned*)(lds + LDS_BYTES - 512 + 320)); posted = true; } else xcd_barrier(xb); }
#define PHASE(k, ...) if (PH(k) && lo <= (k) && (k) < hi) { if ((k) > lo) SEAM(k) PROBE_TICK(k) __VA_ARGS__ }
    PHASE(0, phase_prep0(p, lds);)
    PHASE(1, run_gemm(lds, HB, DM, WIN, DM, S, UC, DM, EpiBf16<0>{UB, UC});)
    PHASE(2, phase_tok0(p, lds);)
    PHASE(3, run_gemm(lds, (const bf16_t*)(ws + WS_ALORA), 512, (const bf16_t*)(ws + WS_LORA), 512, S, 3072, 512, EpiBf16<0>{(bf16_t*)(dob + DO_RWX), 3072});)
    if (PH(3) && lo <= 3 && 3 < hi) { run_gemm(lds, (const bf16_t*)(ws + WS_KCVC), 2048, (const bf16_t*)(ws + WS_CMPW), 4096, 4096, 256, 4096, EpiF32{(float*)(ws + WS_CMPC), 256}); }
    PHASE(4, phase_cmpfin(p, lds);)
    unsigned long long scan_t = 0ull;
    PHASE(5, phase_mix0(p, lds, scan_t);)
    PHASE(6, phase_rwfin(p);)
    PHASE(7, run_gemm(lds, HB, DM, WOUT, DM, S, DM, DM, EpiResid{uni_ptr(p.in[0]), kp.out});)
    PHASE(8, rmsnorm_rows(p.out, p.in[2], HB, S);)
    PHASE(9, run_gemm(lds, HB, DM, W1, DM, 8192, FF, DM, EpiBf16<1>{ZB, FF});)
    PHASE(10, run_gemm(lds, ZB, FF, W2, FF, 8192, DM, FF, EpiResid{kp.out, X2});)
    PHASE(11, run_gemm(lds, HB + (size_t)8192 * DM, DM, W1, DM, 8192, FF, DM, EpiBf16<1>{ZB, FF});)
    PHASE(12, run_gemm(lds, ZB, FF, W2, FF, 8192, DM, FF, EpiResid{kp.out + (size_t)8192 * DM, X2 + (size_t)8192 * DM});)
    PHASE(13, phase_prep1(p, lds);)
    PHASE(14, run_gemm(lds, HB, DM, WIN, DM, S, UC, DM, EpiBf16<0>{UB, UC});)
    PHASE(15, phase_conv(p);)
    PHASE(16, run_gemm(lds, HB, 1024, (const bf16_t*)(ws + WS_LRUG), 1024, S, 2048, 1024, EpiBf16<0>{(bf16_t*)(dob + DO_RG), 2048});)
    PHASE(17, lru_chunk(p, false); hgrn_a(p, lds);)
    PHASE(18, if (blockIdx.x >= gridDim.x - 2) lru_carry(p, (int)(blockIdx.x - (gridDim.x - 2)) * 512 + (int)threadIdx.x); else hgrn_b(p);)
    PHASE(19, lru_chunk(p, true); hgrn_c(p, lds);)
    PHASE(20, run_gemm(lds, HB, DM, WOUT, DM, S, DM, DM, EpiResid{X2, kp.out});)
    PHASE(21, rmsnorm_rows(p.out, p.in[2] + DM, HB, S);)
    PHASE(22, run_gemm(lds, HB, DM, W1, DM, 8192, FF, DM, EpiBf16<1>{ZB, FF});)
    PHASE(23, run_gemm(lds, ZB, FF, W2, FF, 8192, DM, FF, EpiResid{kp.out, kp.out});)
    PHASE(24, run_gemm(lds, HB + (size_t)8192 * DM, DM, W1, DM, 8192, FF, DM, EpiBf16<1>{ZB, FF});)
    PHASE(25, run_gemm(lds, ZB, FF, W2, FF, 8192, DM, FF, EpiResid{kp.out + (size_t)8192 * DM, kp.out + (size_t)8192 * DM});)
#undef PHASE
#ifdef PROBE_SYNCS
    for (int i = 0; i < PROBE_SYNCS; ++i) xcd_barrier(xb);
#endif
#ifdef PROBE_MASK
    if (blockIdx.x == 0) { __syncthreads(); PROBE_TICK(26)
#ifdef PROBE_SCAN
        t_acc = scan_t;
#endif
        const unsigned long long t_end = wall_clock64(); while (wall_clock64() - t_end < PROBE_MULT * t_acc) __builtin_amdgcn_s_sleep(32); }
#endif
}

extern "C" void kernel_launch(void* const* d_in, const int* in_sizes, int n_in, void* d_out, int out_size, void* d_ws, size_t ws_size, hipStream_t stream) {
    static int grid = 0;
    if (grid == 0) {
        if (n_in != 32 || out_size != S * DM || ws_size < WS_END) { fprintf(stderr, "kernel_launch: unexpected problem (n_in %d out %d ws %zu)\n", n_in, out_size, ws_size); grid = -1; return; }
        int dev = 0, cus = 0, per_cu = 0;
        hipGetDevice(&dev); hipDeviceGetAttribute(&cus, hipDeviceAttributeMultiprocessorCount, dev);
        if (hipFuncSetAttribute((const void*)mk_forward, hipFuncAttributeMaxDynamicSharedMemorySize, LDS_BYTES) != hipSuccess) { fprintf(stderr, "kernel_launch: hipFuncSetAttribute failed\n"); grid = -1; return; }
        if (hipOccupancyMaxActiveBlocksPerMultiprocessor(&per_cu, (const void*)mk_forward, 512, LDS_BYTES) != hipSuccess || per_cu < 1) { fprintf(stderr, "kernel_launch: occupancy query says %d\n", per_cu); per_cu = 1; }
        (void)hipGetLastError();
        grid = cus * 1;
        fprintf(stderr, "kernel_launch: cus %d per_cu %d grid %d\n", cus, per_cu, grid);
    }
    if (grid < 0) return;
    Params p{};
    for (int i = 0; i < 32; ++i) p.in[i] = (const float*)d_in[i];
    p.out = (float*)d_out; p.ws = (unsigned char*)d_ws;
#if MK_PER_PHASE
    for (int ph = 0; ph < NPHASE; ++ph) { p.ph_lo = ph; p.ph_hi = ph + 1; hipLaunchKernelGGL(mk_forward, dim3(grid), dim3(512), LDS_BYTES, stream, p); }
#else
    p.ph_lo = 0; p.ph_hi = NPHASE;
    void* args[] = {(void*)&p};
    hipError_t e = hipLaunchCooperativeKernel((const void*)mk_forward, dim3(grid), dim3(512), args, LDS_BYTES, stream);
    if (e != hipSuccess) fprintf(stderr, "cooperative launch failed: %s (grid %d)\n", hipGetErrorString(e), grid);
#endif
}
```

```cpp
#include <hip/hip_runtime.h>
#include <hip/hip_cooperative_groups.h>
#include <cstdio>
namespace cg = cooperative_groups;
#ifndef MK_PER_PHASE
#define MK_PER_PHASE 0
#endif
namespace pg8 {
#define PG8_LAS __attribute__((address_space(3)))
typedef unsigned short bf16_t;
typedef short bf16x8 __attribute__((ext_vector_type(8)));
typedef float f32x4 __attribute__((ext_vector_type(4)));
typedef unsigned u32x4 __attribute__((ext_vector_type(4)));
constexpr int BM = 256, BK = 64, HALF = 128, HTB = HALF * BK * 2  , STAGE_BYTES = 8 * HTB, NXCD = 8, WGM = 8;

__host__ __device__ __forceinline__ int lds_byte(int r, int c) { const int st = (r >> 4) * 2 + (c >> 5), rr = r & 15, cc = c & 31, ob = rr * 64 + cc * 2; return st * 1024 + (ob ^ (((ob >> 9) & 1) << 5)); }
__host__ __device__ __forceinline__ void stage_rc(int b, int& R, int& C) { const int st = b / 1024, sb = b % 1024, swz = sb ^ (((sb >> 9) & 1) << 5); R = (st >> 1) * 16 + swz / 64; C = (st & 1) * 32 + (swz % 64) / 2; }
__host__ __device__ __forceinline__ int perm32(int rho) { const int n = rho >> 4, i = rho & 15; return 8 * (i >> 2) + 4 * n + (i & 3); }

struct Unit { int pm, pn; };
struct Gemm { const bf16_t* A; const bf16_t* Bt; int M, N, K, lda, ldb; };

struct StaticOrder {
    int nM, nN, nwg, G, c;
    __host__ __device__ void init(int M, int N, int G_, int c_) { nM = M / BM; nN = N / BM; nwg = nM * nN; G = G_; c = c_; }
    __host__ __device__ bool next(int i, Unit& u) const {
        const long L = (long)i * G + c; if (L >= nwg) return false;
        int wgid = (int)L; { const int q = nwg / NXCD, r = nwg % NXCD, xcd = wgid % NXCD, off = wgid / NXCD; wgid = (xcd < r ? xcd * (q + 1) : r * (q + 1) + (xcd - r) * q) + off; }
        const int nig = WGM * nN, gid = wgid / nig, fm = gid * WGM, gsz = (nM - fm) < WGM ? (nM - fm) : WGM;
        u.pm = fm + ((wgid % nig) % gsz); u.pn = (wgid % nig) / gsz; return true;
    }
    __device__ __forceinline__ void a_ready(const Unit&) const {}
    __device__ __forceinline__ void done(const Unit&) const {}
};
__device__ __forceinline__ unsigned cvt_pk_bf16(float lo, float hi) { unsigned r; asm volatile("v_cvt_pk_bf16_f32 %0, %1, %2" : "=v"(r) : "v"(lo), "v"(hi)); return r; }
typedef float f32x2 __attribute__((ext_vector_type(2)));
template <class Epi, class Sched, bool STAMP = false>
__device__ __forceinline__ void gemm_phase(PG8_LAS unsigned char* lds, const Gemm g, const Sched& S, const Epi& E, unsigned long long* stamps) {
    const int tid = threadIdx.x, wid = __builtin_amdgcn_readfirstlane(tid >> 6), lane = tid & 63, wr = wid >> 2, wc = wid & 3, fr = lane & 15, fq = lane >> 4;
    const int K = g.K, nt = K / BK;
    int ts_lo = 0, ts_hi = 0, nts = 0; const unsigned long long rt_entry = STAMP ? (unsigned long long)wall_clock64() : 0ull;
#define PG8_STAMP() do { if (STAMP && wid == 0 && nts < 64) { const unsigned long long _c = (unsigned long long)clock64(); \
        ts_lo = (lane == nts) ? (int)(unsigned)_c : ts_lo; ts_hi = (lane == nts) ? (int)(unsigned)(_c >> 32) : ts_hi; ++nts; } } while (0)
    PG8_STAMP();
    unsigned voffA[2], voffB[2];
#pragma unroll
    for (int i = 0; i < 2; ++i) { int R, C; stage_rc(tid * 16 + i * 8192, R, C); const int Rb = Epi::PERM ? ((R & ~31) + perm32(R & 31)) : R;
        voffA[i] = (unsigned)(R * g.lda + C) * 2u; voffB[i] = (unsigned)(Rb * g.ldb + C) * 2u; }
    const size_t kstep = (size_t)(BK * 2);
    const size_t hstepA = (size_t)HALF * g.lda * 2, hstepB = (size_t)HALF * g.ldb * 2;
    const size_t tstepA = 2 * hstepA, tstepB = 2 * hstepB;
    const unsigned ldsw = (unsigned)wid * 1024u;
    const int aoff = lds_byte(wr * 64 + fr, fq * 8), boff = lds_byte(wc * 32 + fr, fq * 8);
#define PG8_SA(b, h) (((b) * 2 + (h)) * HTB)
#define PG8_SB(b, h) ((4 + (b) * 2 + (h)) * HTB)
#define PG8_STAGE(bufoff, gbase, voff) do { _Pragma("unroll") for (int _i = 0; _i < 2; ++_i) \
        __builtin_amdgcn_global_load_lds((const unsigned*)((const char*)(gbase) + (voff)[_i]), (PG8_LAS unsigned*)(lds + (bufoff) + ldsw + _i * 8192), 16, 0, 0); } while (0)
#define PG8_LDA(dst, b, h) do { _Pragma("unroll") for (int m = 0; m < 4; ++m) _Pragma("unroll") for (int k = 0; k < 2; ++k) dst[m][k] = *(const PG8_LAS bf16x8*)(lds + PG8_SA(b, h) + aoff + m * 2048 + k * 1024); } while (0)
#define PG8_LDB(dst, b, h) do { _Pragma("unroll") for (int n = 0; n < 2; ++n) _Pragma("unroll") for (int k = 0; k < 2; ++k) dst[n][k] = *(const PG8_LAS bf16x8*)(lds + PG8_SB(b, h) + boff + n * 2048 + k * 1024); } while (0)
#define PG8_MMA(ai, bj, At, Bt) do { __builtin_amdgcn_s_setprio(1); _Pragma("unroll") for (int m = 0; m < 4; ++m) _Pragma("unroll") for (int n = 0; n < 2; ++n) _Pragma("unroll") for (int k = 0; k < 2; ++k) \
        acc[ai][bj][m][n] = __builtin_amdgcn_mfma_f32_16x16x32_bf16(Bt[n][k], At[m][k], acc[ai][bj][m][n], 0, 0, 0); __builtin_amdgcn_s_setprio(0); } while (0)
#define PG8_WAIT_V(n) asm volatile("s_waitcnt vmcnt(" #n ")" ::: "memory")
#define PG8_WAIT_L(n) asm volatile("s_waitcnt lgkmcnt(" #n ")" ::: "memory")
#define PG8_BAR __builtin_amdgcn_s_barrier()
#define PG8_SCHED __builtin_amdgcn_sched_barrier(0)
    Unit cur, nxt; int ui = 0;
    if (!S.next(0, cur)) return;
    f32x4 acc[2][2][4][2];
#pragma unroll
    for (int a = 0; a < 2; ++a)
#pragma unroll
        for (int b = 0; b < 2; ++b)
#pragma unroll
            for (int m = 0; m < 4; ++m)
#pragma unroll
                for (int n = 0; n < 2; ++n) acc[a][b][m][n] = (f32x4){0.f, 0.f, 0.f, 0.f};
    bf16x8 At[4][2], B0[2][2], B1[2][2];
    const char* cA = (const char*)g.A + (size_t)cur.pm * tstepA; const char* cB = (const char*)g.Bt + (size_t)cur.pn * tstepB;
    S.a_ready(cur);
    PG8_STAGE(PG8_SB(0, 0), cB, voffB); PG8_STAGE(PG8_SA(0, 0), cA, voffA); PG8_STAGE(PG8_SB(0, 1), cB + hstepB, voffB); PG8_STAGE(PG8_SA(0, 1), cA + hstepA, voffA);
    if (wr == 1) PG8_BAR;
    PG8_WAIT_V(4); PG8_BAR;
    PG8_STAGE(PG8_SB(1, 0), cB + kstep, voffB); PG8_STAGE(PG8_SA(1, 0), cA + kstep, voffA); PG8_STAGE(PG8_SB(1, 1), cB + hstepB + kstep, voffB);
    PG8_WAIT_V(6); PG8_BAR;
    PG8_STAMP();
    for (;;) {
        const bool has_next = S.next(ui + 1, nxt);
        const char* nA = has_next ? (const char*)g.A + (size_t)nxt.pm * tstepA : cA; const char* nB = has_next ? (const char*)g.Bt + (size_t)nxt.pn * tstepB : cB;
        for (int t = 0; t < nt; t += 2) {
            const bool last = (t == nt - 2);
            const char* a1 = cA + (size_t)(t + 1) * kstep;
            const char* a2 = last ? nA : cA + (size_t)(t + 2) * kstep; const char* b2 = last ? nB : cB + (size_t)(t + 2) * kstep;
            const char* a3 = a2 + kstep; const char* b3 = b2 + kstep;
            if (last && has_next) S.a_ready(nxt);
            PG8_LDB(B0, 0, 0); PG8_SCHED; PG8_LDA(At, 0, 0); PG8_STAGE(PG8_SA(1, 1), a1 + hstepA, voffA);
            PG8_WAIT_L(8); PG8_BAR; PG8_WAIT_L(0); PG8_MMA(0, 0, At, B0); PG8_BAR; PG8_SCHED;
            PG8_LDB(B1, 0, 1); PG8_STAGE(PG8_SB(0, 0), b2, voffB);
            PG8_BAR; PG8_WAIT_L(0); PG8_MMA(0, 1, At, B1); PG8_BAR;
            PG8_LDA(At, 0, 1); PG8_STAGE(PG8_SA(0, 0), a2, voffA);
            PG8_BAR; PG8_WAIT_L(0); PG8_MMA(1, 0, At, B0); PG8_BAR; PG8_SCHED;
            PG8_STAGE(PG8_SB(0, 1), b2 + hstepB, voffB);
            PG8_WAIT_V(6); PG8_BAR; PG8_MMA(1, 1, At, B1); PG8_BAR;
            PG8_LDB(B0, 1, 0); PG8_SCHED; PG8_LDA(At, 1, 0); PG8_STAGE(PG8_SA(0, 1), a2 + hstepA, voffA);
            PG8_WAIT_L(8); PG8_BAR; PG8_WAIT_L(0); PG8_MMA(0, 0, At, B0); PG8_BAR; PG8_SCHED;
            PG8_LDB(B1, 1, 1); PG8_STAGE(PG8_SB(1, 0), b3, voffB);
            PG8_BAR; PG8_WAIT_L(0); PG8_MMA(0, 1, At, B1); PG8_BAR;
            PG8_LDA(At, 1, 1); PG8_STAGE(PG8_SA(1, 0), a3, voffA);
            PG8_BAR; PG8_WAIT_L(0); PG8_MMA(1, 0, At, B0); PG8_BAR; PG8_SCHED;
            PG8_STAGE(PG8_SB(1, 1), b3 + hstepB, voffB);
            PG8_WAIT_V(6); PG8_BAR; PG8_MMA(1, 1, At, B1); PG8_BAR;
        }
        PG8_STAMP();
        if constexpr (!Epi::AFTER_DRAIN) { E(acc, cur, wr, wc, fr, fq); S.done(cur); }
        PG8_STAMP();
        if (!has_next) break;
#pragma unroll
        for (int a = 0; a < 2; ++a)
#pragma unroll
            for (int b = 0; b < 2; ++b)
#pragma unroll
                for (int m = 0; m < 4; ++m)
#pragma unroll
                    for (int n = 0; n < 2; ++n) acc[a][b][m][n] = (f32x4){0.f, 0.f, 0.f, 0.f};
        cur = nxt; cA = nA; cB = nB; ++ui;
    }
    PG8_WAIT_V(0);
    if (wr == 0) PG8_BAR;
    PG8_BAR;
    if constexpr (Epi::AFTER_DRAIN) { E.fused(acc, cur, wr, wc, fr, fq, lds, wid, lane); S.done(cur); }
    PG8_STAMP();
    if (STAMP && wid == 0) { stamps[lane] = lane < nts ? (((unsigned long long)(unsigned)ts_hi << 32) | (unsigned)ts_lo) : 0ull;
        if (lane == 62) stamps[62] = rt_entry; if (lane == 63) stamps[63] = (unsigned long long)wall_clock64(); }
#undef PG8_STAMP
#undef PG8_SA
#undef PG8_SB
#undef PG8_STAGE
#undef PG8_LDA
#undef PG8_LDB
#undef PG8_MMA
#undef PG8_WAIT_V
#undef PG8_WAIT_L
#undef PG8_BAR
#undef PG8_SCHED
}
}
using pg8::bf16_t; using pg8::bf16x8; using pg8::f32x4; using pg8::u32x4; using pg8::cvt_pk_bf16;
typedef unsigned u32x2 __attribute__((ext_vector_type(2)));
#define LAS __attribute__((address_space(3)))
constexpr int S = 16384, DM = 2048, FF = 8192, UC = 6144;
constexpr size_t MiB = (size_t)1 << 20;
constexpr size_t WS_WIN = 0, WS_WOUT = 24 * MiB, WS_W1 = 32 * MiB, WS_W2 = 64 * MiB, WS_CMPW = 96 * MiB, WS_LORA = 98 * MiB, WS_LRUG = 96 * MiB, WS_SMALL = 101 * MiB;
constexpr size_t WS_HB = 102 * MiB, WS_X2 = 166 * MiB, WS_U = 294 * MiB, WS_D2 = 486 * MiB, WS_END = 512 * MiB;
constexpr size_t WS_QB = 166 * MiB, WS_KSB = 198 * MiB, WS_KWB = 206 * MiB, WS_KCVC = 214 * MiB, WS_VST = 230 * MiB, WS_VWT = 238 * MiB, WS_YB = 246 * MiB;
constexpr size_t WS_ALORA = 486 * MiB, WS_CMPC = 502 * MiB, WS_GT = 506 * MiB, WS_KCB = 508 * MiB, WS_VCT = 508 * MiB + 512 * 1024;
constexpr size_t WS_LRUP = 486 * MiB, WS_LRUH = 487 * MiB, WS_HGD = 488 * MiB;
constexpr size_t WS_Z = 294 * MiB;
constexpr size_t DO_RWX = 0;
constexpr size_t DO_RG = 0, DO_HGS = 64 * MiB;
constexpr int LDS_BYTES = 144 * 1024;
constexpr int NPHASE = 26;

struct Params { const float* in[32]; float* out; unsigned char* ws; int ph_lo, ph_hi; };

__device__ __forceinline__ float bf2f(bf16_t b) { return __uint_as_float(((unsigned)b) << 16); }
__device__ __forceinline__ bf16_t f2bf(float f) { unsigned u = __float_as_uint(f); u += 0x7FFFu + ((u >> 16) & 1u); return (bf16_t)(u >> 16); }
__device__ __forceinline__ float wave_sum(float v) {
#pragma unroll
    for (int o = 1; o < 64; o <<= 1) v += __shfl_xor(v, o);
    return v;
}
__device__ __forceinline__ float fexp(float x) { return __builtin_amdgcn_exp2f(x * 1.4426950408889634f); }
__device__ __forceinline__ float flog(float x) { return __builtin_amdgcn_logf(x) * 0.6931471805599453f; }
__device__ __forceinline__ float frcp(float x) { return __builtin_amdgcn_rcpf(x); }
__device__ __forceinline__ float sigm(float x) { return frcp(1.0f + fexp(-x)); }
__device__ __forceinline__ float softplusf(float x) { return x > 20.f ? x : flog(1.0f + fexp(x)); }
__device__ __forceinline__ float ftanh(float x) { return 1.0f - 2.0f * frcp(1.0f + fexp(2.0f * x)); }
__device__ __forceinline__ float row16_sum(float v) {
    v += __int_as_float(__builtin_amdgcn_update_dpp(0, __float_as_int(v), 0xB1, 0xF, 0xF, true));
    v += __int_as_float(__builtin_amdgcn_update_dpp(0, __float_as_int(v), 0x4E, 0xF, 0xF, true));
    v += __int_as_float(__builtin_amdgcn_update_dpp(0, __float_as_int(v), 0x141, 0xF, 0xF, true));
    v += __int_as_float(__builtin_amdgcn_update_dpp(0, __float_as_int(v), 0x140, 0xF, 0xF, true));
    return v;
}
#define MFMA16(a, b, c) __builtin_amdgcn_mfma_f32_16x16x32_bf16((a), (b), (c), 0, 0, 0)

struct EpiF32 {
    static constexpr bool PERM = false, AFTER_DRAIN = false;
    float* C; int ldc;
    __device__ __forceinline__ void operator()(const f32x4 (&acc)[2][2][4][2], const pg8::Unit& u, int wr, int wc, int fr, int fq) const {
        const int row0 = u.pm * 256 + wr * 64 + fr, col0 = u.pn * 256 + wc * 32 + 4 * fq;
#pragma unroll
        for (int ai = 0; ai < 2; ++ai)
#pragma unroll
            for (int m = 0; m < 4; ++m) { float* rowp = C + (size_t)(row0 + ai * 128 + m * 16) * ldc + col0;
#pragma unroll
                for (int bj = 0; bj < 2; ++bj)
#pragma unroll
                    for (int n = 0; n < 2; ++n) *(f32x4*)(rowp + bj * 128 + n * 16) = acc[ai][bj][m][n]; }
    }
};
struct EpiResid {
    static constexpr bool PERM = false, AFTER_DRAIN = false;
    const float* base; float* out;
    __device__ __forceinline__ void operator()(const f32x4 (&acc)[2][2][4][2], const pg8::Unit& u, int wr, int wc, int fr, int fq) const {
        const int row0 = u.pm * 256 + wr * 64 + fr, col0 = u.pn * 256 + wc * 32 + 4 * fq;
#pragma unroll
        for (int ai = 0; ai < 2; ++ai)
#pragma unroll
            for (int m = 0; m < 4; ++m) { const size_t off = (size_t)(row0 + ai * 128 + m * 16) * DM + col0;
#pragma unroll
                for (int bj = 0; bj < 2; ++bj)
#pragma unroll
                    for (int n = 0; n < 2; ++n) { const f32x4 b = *(const f32x4*)(base + off + bj * 128 + n * 16); *(f32x4*)(out + off + bj * 128 + n * 16) = b + acc[ai][bj][m][n]; }
                asm volatile("" ::: "memory"); }
    }
};
template <int ACT  > struct EpiBf16 {
    static constexpr bool PERM = true, AFTER_DRAIN = false;
    bf16_t* O; int ldc;
    __device__ __forceinline__ void operator()(const f32x4 (&acc)[2][2][4][2], const pg8::Unit& u, int wr, int wc, int fr, int fq) const {
        const int row0 = u.pm * 256 + wr * 64 + fr, col0 = u.pn * 256 + wc * 32 + 8 * fq;
#pragma unroll
        for (int ai = 0; ai < 2; ++ai)
#pragma unroll
            for (int m = 0; m < 4; ++m) { bf16_t* rowp = O + (size_t)(row0 + ai * 128 + m * 16) * ldc + col0;
#pragma unroll
                for (int bj = 0; bj < 2; ++bj) { f32x4 v0 = acc[ai][bj][m][0], v1 = acc[ai][bj][m][1];
                    if (ACT == 1) {
#pragma unroll
                        for (int j = 0; j < 4; ++j) { float a = fmaxf(v0[j], 0.f), b = fmaxf(v1[j], 0.f); v0[j] = a * a; v1[j] = b * b; } }
                    u32x4 w; w.x = cvt_pk_bf16(v0[0], v0[1]); w.y = cvt_pk_bf16(v0[2], v0[3]); w.z = cvt_pk_bf16(v1[0], v1[1]); w.w = cvt_pk_bf16(v1[2], v1[3]);
                    *(u32x4*)(rowp + bj * 128) = w; } }
    }
};
template <class Epi> __device__ __forceinline__ void run_gemm(LAS unsigned char* lds, const bf16_t* A, int lda, const bf16_t* Bt, int ldb, int M, int N, int K, const Epi& E) {
    pg8::Gemm g; g.A = A; g.Bt = Bt; g.M = M; g.N = N; g.K = K; g.lda = lda; g.ldb = ldb;
    pg8::StaticOrder so; so.init(M, N, (int)gridDim.x, (int)blockIdx.x);
    __syncthreads();
    pg8::gemm_phase<Epi, pg8::StaticOrder, false>(lds, g, so, E, nullptr);
    __syncthreads();
}

template <typename SrcT> __device__ __forceinline__ void tconv(const SrcT* src, size_t ld, int K, int N, int Npad, bf16_t* dst, size_t dld, const float* bias, int zero_k, LAS float* tile) {
    const int tid = threadIdx.x, nN = Npad / 64, ntiles = (K / 64) * nN;
    const int r = tid >> 4, c4 = tid & 15;
    float v[2][4];
    auto gload = [&](int id) { const int k0 = (id / nN) * 64, n0 = (id % nN) * 64, n = n0 + 4 * c4;
#pragma unroll
        for (int h = 0; h < 2; ++h) { const int k = k0 + r + 32 * h; v[h][0] = v[h][1] = v[h][2] = v[h][3] = 0.f;
            if (n < N && k != zero_k) {
                if constexpr (sizeof(SrcT) == 4) { const f32x4 x = *(const f32x4*)((const float*)src + (size_t)k * ld + n); v[h][0] = x[0]; v[h][1] = x[1]; v[h][2] = x[2]; v[h][3] = x[3]; }
                else { const u32x2 x = *(const u32x2*)((const bf16_t*)src + (size_t)k * ld + n); v[h][0] = bf2f((bf16_t)(x.x & 0xffff)); v[h][1] = bf2f((bf16_t)(x.x >> 16)); v[h][2] = bf2f((bf16_t)(x.y & 0xffff)); v[h][3] = bf2f((bf16_t)(x.y >> 16)); }
                if (bias) { v[h][0] += bias[n]; v[h][1] += bias[n + 1]; v[h][2] += bias[n + 2]; v[h][3] += bias[n + 3]; } } } };
    int id = blockIdx.x;
    if (id < ntiles) gload(id);
    while (id < ntiles) {
        const int k0 = (id / nN) * 64, n0 = (id % nN) * 64, nxt = id + (int)gridDim.x;
#pragma unroll
        for (int h = 0; h < 2; ++h)
#pragma unroll
            for (int j = 0; j < 4; ++j) tile[(r + 32 * h) * 65 + 4 * c4 + j] = v[h][j];
        if (nxt < ntiles) gload(nxt);
        __syncthreads();
        const int nn = tid >> 3, kc = tid & 7; const LAS float* s = tile + (8 * kc) * 65 + nn;
        u32x4 o; o.x = cvt_pk_bf16(s[0], s[65]); o.y = cvt_pk_bf16(s[2 * 65], s[3 * 65]); o.z = cvt_pk_bf16(s[4 * 65], s[5 * 65]); o.w = cvt_pk_bf16(s[6 * 65], s[7 * 65]);
        *(u32x4*)(dst + (size_t)(n0 + nn) * dld + k0 + 8 * kc) = o;
        __syncthreads();
        id = nxt;
    }
}
__device__ __forceinline__ void rmsnorm_rows(const float* X, const float* g, bf16_t* out, int rows) {
    const int lane = threadIdx.x & 63, gw = blockIdx.x * 8 + (threadIdx.x >> 6), NGW = gridDim.x * 8;
    for (int row = gw; row < rows; row += NGW) {
        const f32x4* xr = (const f32x4*)(X + (size_t)row * DM) + lane; f32x4 v[8]; float s = 0.f;
#pragma unroll
        for (int j = 0; j < 8; ++j) { v[j] = xr[64 * j]; s += (v[j][0] * v[j][0] + v[j][1] * v[j][1]) + (v[j][2] * v[j][2] + v[j][3] * v[j][3]); }
        const float rinv = rsqrtf(wave_sum(s) * (1.0f / DM) + 1e-6f);
#pragma unroll
        for (int j = 0; j < 8; ++j) { const f32x4 gv = ((const f32x4*)g)[lane + 64 * j]; u32x2 o; o.x = cvt_pk_bf16(v[j][0] * rinv * gv[0], v[j][1] * rinv * gv[1]); o.y = cvt_pk_bf16(v[j][2] * rinv * gv[2], v[j][3] * rinv * gv[3]);
            *(u32x2*)(out + (size_t)row * DM + 4 * (lane + 64 * j)) = o; }
    }
}
#define XB_TMO      128
#define XB_XCNT(j)  (256  + 64 * (j))
#define XB_XSUB(j)  (1280 + 64 * (j))
#define XB_XGEN(j)  (2304 + 64 * (j))
#define XB_TOP      3328
#define XB_TOPGEN   3392
#define XCD_BAR_WORDS 3456
#define XB_SPIN_CAP (1u << 18)

__device__ __forceinline__ unsigned xb_ld(unsigned* p)              { return __hip_atomic_load(p, __ATOMIC_RELAXED, __HIP_MEMORY_SCOPE_AGENT); }
__device__ __forceinline__ unsigned xb_add(unsigned* p, unsigned v) { return __hip_atomic_fetch_add(p, v, __ATOMIC_RELAXED, __HIP_MEMORY_SCOPE_AGENT); }
__device__ __forceinline__ unsigned xb_xcc_id() { return (unsigned)__builtin_amdgcn_s_getreg((3 << 11) | 20) & 0xFu; }
#define XB_SPIN(cond, bar) do { unsigned _sp = 0; while (cond) { __builtin_amdgcn_s_sleep(1); \
    if ((++_sp & 255u) == 0u) { if (xb_ld(&(bar)[XB_TMO])) break; if (_sp > XB_SPIN_CAP) { atomicAdd(&(bar)[XB_TMO], 1u); break; } } } } while (0)

struct XcdBarrier {
    unsigned* bar; unsigned x;
    volatile LAS unsigned* st;
};

__device__ __forceinline__ XcdBarrier xcd_barrier_post(unsigned* bar, volatile LAS unsigned* st) {
    XcdBarrier b; b.bar = bar; b.x = xb_xcc_id(); b.st = st;
    if (threadIdx.x == 0) (void)xb_add(&bar[XB_XCNT(b.x)], 1u);
    return b;
}
__device__ __forceinline__ void xcd_barrier_complete(unsigned* bar, unsigned x, unsigned& nloc, unsigned& nx) {
    const unsigned G = gridDim.x * gridDim.y * gridDim.z;
    unsigned sum, cnt, mine, sp = 0u;
    for (;;) {
        sum = 0u; cnt = 0u; mine = 0u;
#pragma unroll
        for (unsigned j = 0; j < 16; ++j) { const unsigned c = xb_ld(&bar[XB_XCNT(j)]); sum += c; cnt += (c > 0u) ? 1u : 0u; mine = (j == x) ? c : mine; }
        if (sum == G) break;
        __builtin_amdgcn_s_sleep(1);
        if ((++sp & 255u) == 0u) { if (xb_ld(&bar[XB_TMO])) break; if (sp > XB_SPIN_CAP) { atomicAdd(&bar[XB_TMO], 1u); break; } }
    }
    nloc = mine > 0u ? mine : 1u; nx = cnt > 0u ? cnt : 1u;
}

__device__ __forceinline__ void xcd_barrier(const XcdBarrier& b) {
    asm volatile("s_waitcnt vmcnt(0)" ::: "memory");
    __syncthreads();
    if (threadIdx.x == 0) {
        unsigned* bar = b.bar;
        __builtin_amdgcn_s_waitcnt(0);
        unsigned nloc = b.st[0], nx = b.st[1];
        if (nloc == 0u) { xcd_barrier_complete(bar, b.x, nloc, nx); b.st[0] = nloc; b.st[1] = nx; }
        const unsigned old = xb_add(&bar[XB_XSUB(b.x)], 1u);
        const unsigned gen = old / nloc;
        if (old + 1u == (gen + 1u) * nloc) {
            __builtin_amdgcn_fence(__ATOMIC_RELEASE, "agent");
            asm volatile("s_waitcnt vmcnt(0)" ::: "memory");
            const unsigned og = xb_add(&bar[XB_TOP], 1u);
            const unsigned tg = og / nx;
            if (og + 1u == (tg + 1u) * nx) xb_add(&bar[XB_TOPGEN], 1u);
            else XB_SPIN(xb_ld(&bar[XB_TOPGEN]) == tg, bar);
            __builtin_amdgcn_fence(__ATOMIC_ACQUIRE, "agent");
            xb_add(&bar[XB_XGEN(b.x)], 1u);
            asm volatile("s_waitcnt vmcnt(0)" ::: "memory");
        } else {
            XB_SPIN(xb_ld(&bar[XB_XGEN(b.x)]) == gen, bar);
            __builtin_amdgcn_fence(__ATOMIC_ACQUIRE, "agent");
            asm volatile("s_waitcnt vmcnt(0)" ::: "memory");
        }
    }
    __syncthreads();
}

__device__ __forceinline__ void phase_prep0(const Params& p, LAS unsigned char* lds) {
    unsigned char* ws = p.ws; LAS float* tile = (LAS float*)lds; const int tid = threadIdx.x;
    if (blockIdx.x == gridDim.x - 1) {
        float* sm = (float*)(ws + WS_SMALL);
        if (tid == 256) { const float* g = p.in[7]; float mx[4];
            for (int a = 0; a < 4; ++a) { float m = 0.f; for (int i = 0; i < 128; ++i) m = fmaxf(m, fabsf(g[a * 128 + i])); mx[a] = m; }
            for (int a = 0; a < 3; ++a) sm[256 + a] = 11.3137085f * mx[0] * mx[1 + a] * 1.0002f + 0.01f; }
        if (tid == 257) { unsigned* ctl = (unsigned*)(ws + WS_SMALL + 2048); ctl[0] = 0u; }
        { unsigned* bw = (unsigned*)(ws + WS_SMALL + 4096); for (int i = tid; i < XCD_BAR_WORDS; i += 512) bw[i] = 0u; }
    }
    tconv<float>(p.in[5], 6104, 2048, 6104, 6144, (bf16_t*)(ws + WS_WIN), 2048, nullptr, -1, tile);
    tconv<float>(p.in[6], 2048, 2048, 2048, 2048, (bf16_t*)(ws + WS_WOUT), 2048, nullptr, -1, tile);
    tconv<float>(p.in[3], 8192, 2048, 8192, 8192, (bf16_t*)(ws + WS_W1), 2048, nullptr, -1, tile);
    tconv<float>(p.in[4], 2048, 8192, 2048, 2048, (bf16_t*)(ws + WS_W2), 8192, nullptr, -1, tile);
    tconv<float>(p.in[8], 128, 4096, 128, 128, (bf16_t*)(ws + WS_CMPW), 4096, nullptr, -1, tile);
    tconv<float>(p.in[8] + (size_t)4096 * 128, 128, 4096, 128, 128, (bf16_t*)(ws + WS_CMPW) + (size_t)128 * 4096, 4096, nullptr, -1, tile);
    { bf16_t* LT = (bf16_t*)(ws + WS_LORA); const float *w2 = p.in[12], *a2 = p.in[14], *g2 = p.in[15];
      for (int idx = blockIdx.x * 512 + tid; idx < 3072 * 512; idx += gridDim.x * 512) { const int n = idx >> 9, k = idx & 511; float v = 0.f;
          if (n < 1024) { if (k < 96) v = w2[k * 1024 + n]; }
          else if (n < 2048) { if (k >= 128 && k < 224) v = a2[(k - 128) * 1024 + n - 1024]; }
          else { if (k >= 256) v = g2[(k - 256) * 1024 + n - 2048]; }
          LT[idx] = f2bf(v); } }
    rmsnorm_rows(p.in[0], p.in[1], (bf16_t*)(ws + WS_HB), S);
}
__device__ __forceinline__ void phase_prep1(const Params& p, LAS unsigned char* lds) {
    unsigned char* ws = p.ws; LAS float* tile = (LAS float*)lds; const int tid = threadIdx.x;
    tconv<float>(p.in[21], 6144, 2048, 6144, 6144, (bf16_t*)(ws + WS_WIN), 2048, nullptr, -1, tile);
    tconv<float>(p.in[22], 2048, 2048, 2048, 2048, (bf16_t*)(ws + WS_WOUT), 2048, nullptr, -1, tile);
    tconv<float>(p.in[3] + (size_t)2048 * 8192, 8192, 2048, 8192, 8192, (bf16_t*)(ws + WS_W1), 2048, nullptr, -1, tile);
    tconv<float>(p.in[4] + (size_t)2048 * 8192, 2048, 8192, 2048, 2048, (bf16_t*)(ws + WS_W2), 8192, nullptr, -1, tile);
    { bf16_t* GT_ = (bf16_t*)(ws + WS_LRUG); const float *wa = p.in[25], *wx = p.in[27];
      for (int idx = blockIdx.x * 512 + tid; idx < 2048 * 1024; idx += gridDim.x * 512) { const int n = idx >> 10, k = idx & 1023, ch = n >> 1, blk = ch >> 7, d = ch & 127; float v = 0.f;
          if ((k >> 7) == blk) v = ((n & 1) ? wx : wa)[(blk * 128 + (k & 127)) * 128 + d];
          GT_[idx] = f2bf(v); } }
    rmsnorm_rows((const float*)(ws + WS_X2), p.in[1] + DM, (bf16_t*)(ws + WS_HB), S);
}

__device__ __forceinline__ void up4(u32x2 v, float (&o)[4]) { o[0] = bf2f((bf16_t)(v.x & 0xffff)); o[1] = bf2f((bf16_t)(v.x >> 16)); o[2] = bf2f((bf16_t)(v.y & 0xffff)); o[3] = bf2f((bf16_t)(v.y >> 16)); }
__device__ __forceinline__ void norm_rope16(const bf16_t* src, bf16_t* dst, const float (&ga)[4], const float (&gb)[4], const float (&cs)[4], const float (&sn)[4], int li) {
    float x1[4], x2[4]; up4(*(const u32x2*)(src + 4 * li), x1); up4(*(const u32x2*)(src + 64 + 4 * li), x2);
    float ss = 0.f;
#pragma unroll
    for (int i = 0; i < 4; ++i) ss += x1[i] * x1[i] + x2[i] * x2[i];
    const float rinv = rsqrtf(row16_sum(ss) * (1.0f / 128.f) + 1e-6f);
    float o1[4], o2[4];
#pragma unroll
    for (int i = 0; i < 4; ++i) { const float y1 = x1[i] * rinv * ga[i], y2 = x2[i] * rinv * gb[i]; o1[i] = y1 * cs[i] - y2 * sn[i]; o2[i] = y1 * sn[i] + y2 * cs[i]; }
    u32x2 w1, w2; w1.x = cvt_pk_bf16(o1[0], o1[1]); w1.y = cvt_pk_bf16(o1[2], o1[3]); w2.x = cvt_pk_bf16(o2[0], o2[1]); w2.y = cvt_pk_bf16(o2[2], o2[3]);
    *(u32x2*)(dst + 4 * li) = w1; *(u32x2*)(dst + 64 + 4 * li) = w2;
}
__device__ __forceinline__ void phase_tok0(const Params& p, LAS unsigned char* lds) {
    unsigned char* ws = p.ws; const int lane = threadIdx.x & 63, gw = blockIdx.x * 8 + (threadIdx.x >> 6), NGW = gridDim.x * 8, li = lane & 15, R = lane >> 4;
    const bf16_t* U = (const bf16_t*)(ws + WS_U);
    bf16_t *QB = (bf16_t*)(ws + WS_QB), *KSB = (bf16_t*)(ws + WS_KSB), *KWB = (bf16_t*)(ws + WS_KWB), *KCVC = (bf16_t*)(ws + WS_KCVC), *AL = (bf16_t*)(ws + WS_ALORA);
    float* GT = (float*)(ws + WS_GT);
    const float* gain = p.in[7]; const float* mu = p.in[10];
    if (blockIdx.x < 32 && threadIdx.x < 256) {
        const int tid = threadIdx.x, w = blockIdx.x >> 4, sl = (blockIdx.x & 15) * 2 + (tid >> 7), e = tid & 127;
        const float* pe = p.in[9] + w * 4096 + sl * 128; const float* cw = p.in[8] + ((size_t)w * 4096 + sl * 128) * 128 + e; float s = 0.f;
#pragma unroll 16
        for (int i = 0; i < 128; ++i) s += pe[i] * cw[(size_t)i * 128];
        ((float*)(ws + WS_SMALL + 32768))[(w * 32 + sl) * 128 + e] = s; }
    float g0a[4], g0b[4], gka[4], gkb[4], invf[4];
#pragma unroll
    for (int i = 0; i < 4; ++i) { g0a[i] = gain[4 * li + i]; g0b[i] = gain[64 + 4 * li + i]; const int gk = (R < 2 ? 256 : 384); gka[i] = gain[gk + 4 * li + i]; gkb[i] = gain[gk + 64 + 4 * li + i];
        invf[i] = powf(10000.0f, -((float)(2 * (4 * li + i)) / 128.0f)); }
    for (int t = gw; t < S; t += NGW) {
        const bf16_t* u = U + (size_t)t * UC;
        float sn[4], cs[4];
#pragma unroll
        for (int i = 0; i < 4; ++i) sincosf((float)t * invf[i], &sn[i], &cs[i]);
        norm_rope16(u + R * 128, QB + ((size_t)t * 8 + R) * 128, g0a, g0b, cs, sn, li);
        norm_rope16(u + (4 + R) * 128, QB + ((size_t)t * 8 + 4 + R) * 128, g0a, g0b, cs, sn, li);
        { const int g = R & 1; const bf16_t* src = u + (R < 2 ? 1536 : 2048) + g * 128; bf16_t* dst = (R < 2 ? KSB : KWB) + ((size_t)g * S + t) * 128; norm_rope16(src, dst, gka, gkb, cs, sn, li); }
        { bf16_t* kv = KCVC + ((size_t)R * S + t) * 128;
          *(u32x2*)(kv + 4 * li) = *(const u32x2*)(u + 1024 + R * 128 + 4 * li); *(u32x2*)(kv + 64 + 4 * li) = *(const u32x2*)(u + 1024 + R * 128 + 64 + 4 * li); }
        if (lane < 24) GT[(size_t)t * 24 + lane] = sigm(bf2f(u[2560 + lane]));
        bf16_t* al = AL + (size_t)t * 512;
#pragma unroll
        for (int i = 0; i < 2; ++i) { const int c4 = lane + 64 * i;
            if (c4 < 112) { const int c = 3072 + 4 * c4, col = 2584 + c; float cur[4], prev[4] = {0.f, 0.f, 0.f, 0.f}, o[4]; up4(*(const u32x2*)(u + col), cur); if (t > 0) up4(*(const u32x2*)(u + col - UC), prev);
                const f32x4 m4 = *(const f32x4*)(mu + c);
#pragma unroll
                for (int e = 0; e < 4; ++e) { const float xm = cur[e] + (prev[e] - cur[e]) * m4[e]; o[e] = c < 3168 ? ftanh(xm) : (c < 3264 ? xm : sigm(xm)); }
                const int dst = c < 3168 ? c - 3072 : (c < 3264 ? 128 + c - 3168 : 256 + c - 3264);
                u32x2 w; w.x = cvt_pk_bf16(o[0], o[1]); w.y = cvt_pk_bf16(o[2], o[3]); *(u32x2*)(al + dst) = w; } }
        if (lane < 16) { const u32x2 z = {0u, 0u}; *(u32x2*)(al + (lane < 8 ? 96 : 224 - 32) + 4 * lane) = z; }
    }
    LAS float* tile = (LAS float*)lds;
    tconv<bf16_t>(U + 1792, UC, S, 256, 256, (bf16_t*)(ws + WS_VST), S, nullptr, -1, tile);
    tconv<bf16_t>(U + 2304, UC, S, 256, 256, (bf16_t*)(ws + WS_VWT), S, nullptr, -1, tile);
}
__device__ __forceinline__ void phase_cmpfin(const Params& p, LAS unsigned char* lds) {
    unsigned char* ws = p.ws; const int lane = threadIdx.x & 63, gw = blockIdx.x * 8 + (threadIdx.x >> 6), NGW = gridDim.x * 8;
    const float* C = (const float*)(ws + WS_CMPC); bf16_t* KCB = (bf16_t*)(ws + WS_KCB);
    { LAS float* cbl = (LAS float*)(lds + 32768); const float* part = (const float*)(ws + WS_SMALL + 32768);
      if (threadIdx.x < 256) { const int w = threadIdx.x >> 7, e = threadIdx.x & 127; float s = 0.f;
#pragma unroll
          for (int i = 0; i < 32; ++i) s += part[(w * 32 + i) * 128 + e];
          cbl[threadIdx.x] = s; }
      __syncthreads(); }
    const float* cb = (const float*)((unsigned char*)(LAS unsigned char*)(lds + 32768));
    const float* gain = p.in[7]; const float g1a = gain[128 + lane], g1b = gain[192 + lane];
    const float invf = powf(10000.0f, -((float)(2 * lane) / 128.0f));
    for (int row = gw; row < 2048; row += NGW) { const int n = row & 1023; bf16_t* dst = KCB + (size_t)row * 128;
        if (n == 1023) { dst[lane] = 0; dst[64 + lane] = 0; continue; }
        const float x1 = C[(size_t)row * 256 + lane] + cb[lane], x2 = C[(size_t)row * 256 + 64 + lane] + cb[64 + lane];
        const float rinv = rsqrtf(wave_sum(x1 * x1 + x2 * x2) * (1.0f / 128.f) + 1e-6f);
        const float y1 = x1 * rinv * g1a, y2 = x2 * rinv * g1b; float sn, cs; sincosf((float)(16 * n + 31) * invf, &sn, &cs);
        dst[lane] = f2bf(y1 * cs - y2 * sn); dst[64 + lane] = f2bf(y1 * sn + y2 * cs); }
    { bf16_t* RWX = (bf16_t*)((unsigned char*)p.out + DO_RWX); const float *w0 = p.in[11], *a0 = p.in[13];
      for (int idx = blockIdx.x * 512 + threadIdx.x; idx < S * 512; idx += gridDim.x * 512) { const int t = idx >> 9, c = (idx & 511) * 4; u32x2* pp = (u32x2*)(RWX + (size_t)t * 3072 + c); const u32x2 x = *pp; float v[4];
          v[0] = bf2f((bf16_t)(x.x & 0xffff)); v[1] = bf2f((bf16_t)(x.x >> 16)); v[2] = bf2f((bf16_t)(x.y & 0xffff)); v[3] = bf2f((bf16_t)(x.y >> 16));
          if (c < 1024) {
#pragma unroll
              for (int i = 0; i < 4; ++i) { const float w = -softplusf(-(w0[c + i] + v[i])) - 0.5f; v[i] = -fexp(w); } }
          else {
#pragma unroll
              for (int i = 0; i < 4; ++i) v[i] = sigm(a0[c - 1024 + i] + v[i]); }
          u32x2 o; o.x = cvt_pk_bf16(v[0], v[1]); o.y = cvt_pk_bf16(v[2], v[3]); *pp = o; } }
    LAS float* tile = (LAS float*)lds;
    for (int g = 0; g < 2; ++g)
        tconv<float>(C + (size_t)(2048 + g * 1024) * 256 + 128, 256, 1024, 128, 128, (bf16_t*)(ws + WS_VCT) + (size_t)g * 128 * 1024, 1024, cb + 128, 1023, tile);
}
constexpr int NS_KT = 0, NS_VT = 17408, NS_IMP = 35840, NS_SEL = 69120, NS_UNI = 70144, NS_ITEM = 70176;
__device__ __forceinline__ void ns_stage(LAS unsigned char* lds, const bf16_t* Ksrc, const bf16_t* VTsrc, size_t vld, bool withV) {
    const int tid = threadIdx.x;
#pragma unroll
    for (int i = 0; i < 2; ++i) { const int id = tid + 512 * i, row = id >> 4, ch = id & 15; const u32x4 v = *(const u32x4*)(Ksrc + (size_t)row * 128 + ch * 8); *(LAS u32x4*)(lds + NS_KT + row * 272 + ch * 16) = v; }
    if (withV) {
#pragma unroll
        for (int i = 0; i < 2; ++i) { const int id = tid + 512 * i, d = id >> 3, ch = id & 7; const u32x4 v = *(const u32x4*)(VTsrc + (size_t)d * vld + ch * 8); *(LAS u32x4*)(lds + NS_VT + d * 144 + ch * 16) = v; } }
}
__device__ __forceinline__ void ns_qk(LAS unsigned char* lds, int grp, const bf16x8 (&qf)[4], int lane, f32x4& s0, f32x4& s1) {
    const int i = lane & 15, quad = lane >> 4, krow = 32 * grp + (i >> 2) * 8 + (i & 3);
    s0 = (f32x4){0.f, 0.f, 0.f, 0.f}; s1 = s0;
#pragma unroll
    for (int ks = 0; ks < 4; ++ks) {
        const bf16x8 a0 = *(const LAS bf16x8*)(lds + NS_KT + krow * 272 + (32 * ks + 8 * quad) * 2);
        const bf16x8 a1 = *(const LAS bf16x8*)(lds + NS_KT + (krow + 4) * 272 + (32 * ks + 8 * quad) * 2);
        s0 = MFMA16(a0, qf[ks], s0); s1 = MFMA16(a1, qf[ks], s1); }
}
__device__ __forceinline__ void ns_pv(LAS unsigned char* lds, int grp, const f32x4& p0, const f32x4& p1, int lane, f32x4 (&o)[8]) {
    const int i = lane & 15, quad = lane >> 4;
    union { bf16x8 v; unsigned w[4]; } pf; pf.w[0] = cvt_pk_bf16(p0[0], p0[1]); pf.w[1] = cvt_pk_bf16(p0[2], p0[3]); pf.w[2] = cvt_pk_bf16(p1[0], p1[1]); pf.w[3] = cvt_pk_bf16(p1[2], p1[3]);
#pragma unroll
    for (int dt = 0; dt < 8; ++dt) { const bf16x8 a = *(const LAS bf16x8*)(lds + NS_VT + (16 * dt + i) * 144 + (32 * grp + 8 * quad) * 2); o[dt] = MFMA16(a, pf.v, o[dt]); }
}
__device__ __forceinline__ void nsa_item(const Params& p, LAS unsigned char* lds, int item) {
    unsigned char* ws = p.ws; const int tid = threadIdx.x, lane = tid & 63, w = tid >> 6, c = lane & 15, quad = lane >> 4, tq = c >> 2, j = c & 3;
    const int tile = 511 - (item >> 1), g = item & 1, t0 = tile * 32, t = t0 + 4 * w + tq;
    const bf16_t *QB = (const bf16_t*)(ws + WS_QB), *KSB = (const bf16_t*)(ws + WS_KSB), *KWB = (const bf16_t*)(ws + WS_KWB), *KCB = (const bf16_t*)(ws + WS_KCB);
    const bf16_t *VST = (const bf16_t*)(ws + WS_VST), *VWT = (const bf16_t*)(ws + WS_VWT), *VCT = (const bf16_t*)(ws + WS_VCT);
    const float* GT = (const float*)(ws + WS_GT); const float* sm = (const float*)(ws + WS_SMALL);
    const float sc2 = 0.08838834764831845f * 1.4426950408889634f;
    LAS float* imp = (LAS float*)(lds + NS_IMP) + w * 1040; LAS unsigned* sel = (LAS unsigned*)(lds + NS_SEL) + w * 32; LAS unsigned* uni = (LAS unsigned*)(lds + NS_UNI);
    bf16x8 qf[4];
#pragma unroll
    for (int ks = 0; ks < 4; ++ks) qf[ks] = *(const bf16x8*)(QB + ((size_t)t * 8 + 4 * g + j) * 128 + 32 * ks + 8 * quad);
    f32x4 otot[8], ob[8];
#pragma unroll
    for (int dt = 0; dt < 8; ++dt) { otot[dt] = (f32x4){0.f, 0.f, 0.f, 0.f}; ob[dt] = otot[dt]; }
    for (int i = lane; i < 1040; i += 64) imp[i] = 0.f;
    if (tid < 8) uni[tid] = 0u;
    {
        const float cb2 = sm[256] * 1.4426950408889634f; const int ncb = (t0 >> 4) / 64 + 1; float l = 0.f, linv = 0.f;
        for (int pass = 0; pass < 2; ++pass) {
            for (int blk = 0; blk < ncb; ++blk) {
                __syncthreads();
                ns_stage(lds, KCB + ((size_t)g * 1024 + 64 * blk) * 128, VCT + (size_t)g * 128 * 1024 + 64 * blk, 1024, pass == 1);
                __syncthreads();
#pragma unroll 1
                for (int grp = 0; grp < 2; ++grp) {
                    f32x4 s0, s1; ns_qk(lds, grp, qf, lane, s0, s1);
                    const int nb = 64 * blk + 32 * grp + 8 * quad;
#pragma unroll
                    for (int r = 0; r < 4; ++r) { s0[r] = (16 * (nb + r) + 31 <= t) ? __builtin_amdgcn_exp2f(s0[r] * sc2 - cb2) : 0.f; s1[r] = (16 * (nb + 4 + r) + 31 <= t) ? __builtin_amdgcn_exp2f(s1[r] * sc2 - cb2) : 0.f; }
                    if (pass == 0) { l += (s0[0] + s0[1]) + (s0[2] + s0[3]) + (s1[0] + s1[1]) + (s1[2] + s1[3]); }
                    else {
                        s0 *= linv; s1 *= linv;
                        float m0 = s0[0] + s0[1] + s0[2] + 0.5f * s0[3], n0 = 0.5f * s0[3], m1 = s1[0] + s1[1] + s1[2] + 0.5f * s1[3], n1 = 0.5f * s1[3];
                        m0 += __shfl_xor(m0, 1); m0 += __shfl_xor(m0, 2); n0 += __shfl_xor(n0, 1); n0 += __shfl_xor(n0, 2);
                        m1 += __shfl_xor(m1, 1); m1 += __shfl_xor(m1, 2); n1 += __shfl_xor(n1, 1); n1 += __shfl_xor(n1, 2);
                        if (j == 0) { const int m = nb >> 2; LAS float* ip = imp + tq * 260 + m; atomicAdd((float*)ip, m0); atomicAdd((float*)(ip + 1), n0 + m1); atomicAdd((float*)(ip + 2), n1); }
                        ns_pv(lds, grp, s0, s1, lane, ob);
                    }
                }
            }
            if (pass == 0) { l += __shfl_xor(l, 16); l += __shfl_xor(l, 32); linv = l > 0.f ? 1.0f / l : 0.f; }
        }
        const float gc = GT[(size_t)t * 24 + 4 * g + j];
#pragma unroll
        for (int dt = 0; dt < 8; ++dt) { otot[dt] += ob[dt] * gc; ob[dt] = (f32x4){0.f, 0.f, 0.f, 0.f}; }
    }
    __syncthreads();
    {
        const int R = lane >> 4, li = lane & 15, cur = (t0 + 4 * w + R) >> 6; LAS unsigned* selw = sel + R * 8;
        if (li < 8) selw[li] = 0u;
        if (cur < 16) { if (li == 0) selw[0] = (2u << cur) - 1u; }
        else {
            unsigned key[16];
#pragma unroll
            for (int i = 0; i < 16; ++i) { const int m = li + 16 * i; const float v = imp[R * 260 + m]; key[i] = (m >= 1 && m <= cur - 2) ? ((__float_as_uint(v) & 0xFFFFFF00u) | (unsigned)(255 - m)) : 0u; }
            for (int round = 0; round < 13; ++round) {
                unsigned bk = key[0];
#pragma unroll
                for (int i = 1; i < 16; ++i) bk = bk > key[i] ? bk : key[i];
#pragma unroll
                for (int o = 1; o < 16; o <<= 1) { const unsigned ok = (unsigned)__shfl_xor((int)bk, o); bk = bk > ok ? bk : ok; }
#pragma unroll
                for (int i = 0; i < 16; ++i) key[i] = key[i] == bk ? 0u : key[i];
                const int ms = 255 - (int)(bk & 255u);
                if (li == 0) selw[ms >> 5] |= 1u << (ms & 31);
            }
            if (li == 0) { selw[0] |= 1u; selw[cur >> 5] |= 1u << (cur & 31); selw[(cur - 1) >> 5] |= 1u << ((cur - 1) & 31); }
        }
    }
    __syncthreads();
    if (lane < 32) atomicOr((unsigned*)(uni + (lane & 7)), sel[lane]);
    __syncthreads();
    {
        const float cb2 = sm[257] * 1.4426950408889634f; const int ncur = (t0 + 31) >> 6; float l = 0.f;
        for (int m = 0; m <= ncur; ++m) {
            if (!((uni[m >> 5] >> (m & 31)) & 1u)) continue;
            __syncthreads();
            ns_stage(lds, KSB + ((size_t)g * S + 64 * m) * 128, VST + (size_t)g * 128 * S + 64 * m, S, true);
            __syncthreads();
            const bool mybit = (sel[tq * 8 + (m >> 5)] >> (m & 31)) & 1u;
            if (!__any(mybit)) continue;
#pragma unroll 1
            for (int grp = 0; grp < 2; ++grp) {
                f32x4 s0, s1; ns_qk(lds, grp, qf, lane, s0, s1);
                const int kb = 64 * m + 32 * grp + 8 * quad;
#pragma unroll
                for (int r = 0; r < 4; ++r) { s0[r] = (mybit && kb + r <= t) ? __builtin_amdgcn_exp2f(s0[r] * sc2 - cb2) : 0.f; s1[r] = (mybit && kb + 4 + r <= t) ? __builtin_amdgcn_exp2f(s1[r] * sc2 - cb2) : 0.f; }
                l += (s0[0] + s0[1]) + (s0[2] + s0[3]) + (s1[0] + s1[1]) + (s1[2] + s1[3]);
                ns_pv(lds, grp, s0, s1, lane, ob);
            }
        }
        l += __shfl_xor(l, 16); l += __shfl_xor(l, 32);
        const float gs = GT[(size_t)t * 24 + 8 + 4 * g + j] / l;
#pragma unroll
        for (int dt = 0; dt < 8; ++dt) { otot[dt] += ob[dt] * gs; ob[dt] = (f32x4){0.f, 0.f, 0.f, 0.f}; }
    }
    {
        const float cb2 = sm[258] * 1.4426950408889634f; const int mb0 = (t0 >= 511 ? (t0 - 511) : 0) >> 6, mb1 = t0 >> 6; float l = 0.f;
        for (int m = mb0; m <= mb1; ++m) {
            __syncthreads();
            ns_stage(lds, KWB + ((size_t)g * S + 64 * m) * 128, VWT + (size_t)g * 128 * S + 64 * m, S, true);
            __syncthreads();
#pragma unroll 1
            for (int grp = 0; grp < 2; ++grp) {
                f32x4 s0, s1; ns_qk(lds, grp, qf, lane, s0, s1);
                const int kb = 64 * m + 32 * grp + 8 * quad;
#pragma unroll
                for (int r = 0; r < 4; ++r) { const int d0 = t - (kb + r), d1 = t - (kb + 4 + r);
                    s0[r] = (d0 >= 0 && d0 < 512) ? __builtin_amdgcn_exp2f(s0[r] * sc2 - cb2) : 0.f; s1[r] = (d1 >= 0 && d1 < 512) ? __builtin_amdgcn_exp2f(s1[r] * sc2 - cb2) : 0.f; }
                l += (s0[0] + s0[1]) + (s0[2] + s0[3]) + (s1[0] + s1[1]) + (s1[2] + s1[3]);
                ns_pv(lds, grp, s0, s1, lane, ob);
            }
        }
        l += __shfl_xor(l, 16); l += __shfl_xor(l, 32);
        const float gw_ = GT[(size_t)t * 24 + 16 + 4 * g + j] / l;
#pragma unroll
        for (int dt = 0; dt < 8; ++dt) otot[dt] += ob[dt] * gw_;
    }
    bf16_t* Y = (bf16_t*)(ws + WS_HB) + (size_t)t * DM + 512 * g + 128 * j + 4 * quad;
#pragma unroll
    for (int dt = 0; dt < 8; ++dt) { u32x2 o; o.x = cvt_pk_bf16(otot[dt][0], otot[dt][1]); o.y = cvt_pk_bf16(otot[dt][2], otot[dt][3]); *(u32x2*)(Y + 16 * dt) = o; }
    __syncthreads();
}

typedef float f32x2v __attribute__((ext_vector_type(2)));
constexpr int NSCAN = 64;
__device__ __forceinline__ void rwkv_scan(const Params& p, LAS unsigned char* lds) {
    unsigned char* ws = p.ws; const int tid = threadIdx.x, lane = tid & 63, w = tid >> 6;
    const int h = blockIdx.x >> 2, qr = blockIdx.x & 3;
    const bf16_t* U = (const bf16_t*)(ws + WS_U); const bf16_t* RWX = (const bf16_t*)((unsigned char*)p.out + DO_RWX);
    bf16_t* YB = (bf16_t*)(ws + WS_YB);
    LAS float* ybuf = (LAS float*)(lds + 98304);
    if (w >= 4) {
        const int pt = tid - 256, j0 = 4 * (pt & 15);
        float kkw[4], kaw[4], mur[4], muk[4], muv[4];
#pragma unroll
        for (int i = 0; i < 4; ++i) { kkw[i] = p.in[16][h * 64 + j0 + i]; kaw[i] = p.in[17][h * 64 + j0 + i]; mur[i] = p.in[10][h * 64 + j0 + i]; muk[i] = p.in[10][1024 + h * 64 + j0 + i]; muv[i] = p.in[10][2048 + h * 64 + j0 + i]; }
        auto unpack = [&](u32x2 v, float (&o)[4]) { o[0] = bf2f((bf16_t)(v.x & 0xffff)); o[1] = bf2f((bf16_t)(v.x >> 16)); o[2] = bf2f((bf16_t)(v.y & 0xffff)); o[3] = bf2f((bf16_t)(v.y >> 16)); };
        struct Raw { u32x2 rc, kc, vc, rp, kp, vp, lw, aa; };
        auto gload = [&](Raw& q, int chunk, int hs) { const int ss = (pt >> 4) + 16 * hs, t = 32 * chunk + ss;
            const bf16_t* u = U + (size_t)t * UC + 2584 + h * 64 + j0; const u32x2 z = {0u, 0u};
            q.rc = *(const u32x2*)u; q.kc = *(const u32x2*)(u + 1024); q.vc = *(const u32x2*)(u + 2048);
            q.rp = z; q.kp = z; q.vp = z; if (t > 0) { q.rp = *(const u32x2*)(u - UC); q.kp = *(const u32x2*)(u - UC + 1024); q.vp = *(const u32x2*)(u - UC + 2048); }
            q.lw = *(const u32x2*)(RWX + (size_t)t * 3072 + h * 64 + j0); q.aa = *(const u32x2*)(RWX + (size_t)t * 3072 + 1024 + h * 64 + j0); };
        auto stage = [&](const Raw& q, int chunk, int hs) { const int ss = (pt >> 4) + 16 * hs;
            float a[4], b[4], r[4], k[4], v[4], lwf[4], aaf[4];
            unpack(q.rc, a); unpack(q.rp, b);
#pragma unroll
            for (int i = 0; i < 4; ++i) r[i] = a[i] + (b[i] - a[i]) * mur[i];
            unpack(q.kc, a); unpack(q.kp, b);
#pragma unroll
            for (int i = 0; i < 4; ++i) k[i] = a[i] + (b[i] - a[i]) * muk[i];
            unpack(q.vc, a); unpack(q.vp, b);
#pragma unroll
            for (int i = 0; i < 4; ++i) v[i] = a[i] + (b[i] - a[i]) * muv[i];
            unpack(q.lw, lwf); unpack(q.aa, aaf);
            float kk[4], sq = 0.f;
#pragma unroll
            for (int i = 0; i < 4; ++i) { kk[i] = k[i] * kkw[i]; sq += kk[i] * kk[i]; }
            sq = row16_sum(sq); const float kn = __builtin_amdgcn_rsqf(fmaxf(sq, 1e-24f));
            f32x4 W_, A_, B_, K_, R_, V_;
#pragma unroll
            for (int i = 0; i < 4; ++i) { const float kki = kk[i] * kn; W_[i] = __expf(lwf[i]); A_[i] = -kki; B_[i] = kki * aaf[i]; K_[i] = k[i] * (1.0f + (aaf[i] - 1.0f) * kaw[i]); R_[i] = r[i]; V_[i] = v[i]; }
            LAS unsigned char* bp = lds + (chunk & 1) * 49152 + (ss * 64 + j0) * 4;
            *(LAS f32x4*)(bp) = W_; *(LAS f32x4*)(bp + 8192) = A_; *(LAS f32x4*)(bp + 16384) = B_; *(LAS f32x4*)(bp + 24576) = K_; *(LAS f32x4*)(bp + 32768) = R_; *(LAS f32x4*)(bp + 40960) = V_; };
        Raw c0, c1, n0, n1;
        gload(c0, 0, 0); gload(c1, 0, 1);
        for (int chunk = -1; chunk < 512; ++chunk) {
            if (chunk + 2 < 512) { gload(n0, chunk + 2, 0); gload(n1, chunk + 2, 1); }
            if (chunk + 1 < 512) { stage(c0, chunk + 1, 0); stage(c1, chunk + 1, 1); }
            if (chunk >= 1) { const int cc = chunk - 1, ss = pt >> 3, pr = pt & 7; const LAS float* yb = ybuf + (cc & 1) * 512 + ss * 16 + 2 * pr;
                *(unsigned*)(YB + (size_t)(32 * cc + ss) * 1024 + h * 64 + 16 * qr + 2 * pr) = cvt_pk_bf16(yb[0], yb[1]); }
            __syncthreads();
            c0 = n0; c1 = n1;
        }
        { const int c1 = 511, ss = pt >> 3, pr = pt & 7; const LAS float* yb = ybuf + (c1 & 1) * 512 + ss * 16 + 2 * pr;
          *(unsigned*)(YB + (size_t)(32 * c1 + ss) * 1024 + h * 64 + 16 * qr + 2 * pr) = cvt_pk_bf16(yb[0], yb[1]); }
    } else {
        const int iloc = 4 * w + (lane >> 4), irow = 16 * qr + iloc, jj = 4 * (lane & 15);
        f32x2v S01 = {0.f, 0.f}, S23 = {0.f, 0.f};
        __syncthreads();
        for (int chunk = 0; chunk < 512; ++chunk) {
            LAS unsigned char* bp = lds + (chunk & 1) * 49152 + jj * 4; LAS float* vb = (LAS float*)(lds + (chunk & 1) * 49152 + 40960) + irow; LAS float* yb = ybuf + (chunk & 1) * 512 + iloc;
            struct Ops { f32x4 W[4], A[4], B[4], K[4], R[4]; float v[4]; };
            Ops q0, q1;
            auto load4 = [&](Ops& q, int s0) {
#pragma unroll
                for (int i = 0; i < 4; ++i) { const int s = s0 + i; q.W[i] = *(const LAS f32x4*)(bp + s * 256); q.A[i] = *(const LAS f32x4*)(bp + 8192 + s * 256); q.B[i] = *(const LAS f32x4*)(bp + 16384 + s * 256);
                    q.K[i] = *(const LAS f32x4*)(bp + 24576 + s * 256); q.R[i] = *(const LAS f32x4*)(bp + 32768 + s * 256); q.v[i] = vb[s * 64]; } };
            auto comp4 = [&](const Ops& q, int s0) {
                float yp[4];
#pragma unroll
                for (int i = 0; i < 4; ++i) {
                    const f32x4 W_ = q.W[i], A_ = q.A[i], B_ = q.B[i], K_ = q.K[i], R_ = q.R[i]; const float v = q.v[i];
                    const f32x2v vv = {v, v};
                    const f32x2v d = S01 * (f32x2v){A_[0], A_[1]} + S23 * (f32x2v){A_[2], A_[3]};
                    const f32x2v t01 = S01 * (f32x2v){W_[0], W_[1]} + vv * (f32x2v){K_[0], K_[1]}, t23 = S23 * (f32x2v){W_[2], W_[3]} + vv * (f32x2v){K_[2], K_[3]};
                    const float sa = row16_sum(d.x + d.y); const f32x2v sav = {sa, sa};
                    S01 = sav * (f32x2v){B_[0], B_[1]} + t01;
                    S23 = sav * (f32x2v){B_[2], B_[3]} + t23;
                    const f32x2v yd = S01 * (f32x2v){R_[0], R_[1]} + S23 * (f32x2v){R_[2], R_[3]};
                    yp[i] = yd.x + yd.y;
                }
#pragma unroll
                for (int i = 0; i < 4; ++i) yp[i] = row16_sum(yp[i]);
#pragma unroll
                for (int i = 0; i < 4; ++i) yb[(s0 + i) * 16] = yp[i]; };
            load4(q0, 0);
#pragma unroll 1
            for (int b2 = 0; b2 < 4; ++b2) {
                load4(q1, 8 * b2 + 4);
                comp4(q0, 8 * b2);
                if (b2 < 3) load4(q0, 8 * b2 + 8);
                comp4(q1, 8 * b2 + 4);
            }
            __syncthreads();
        }
    }
}
__device__ __forceinline__ void phase_mix0(const Params& p, LAS unsigned char* lds, unsigned long long& g_probe_scan) {
#ifdef PROBE_SCAN
    { const unsigned long long ts0 = wall_clock64(); if (blockIdx.x < NSCAN) rwkv_scan(p, lds); g_probe_scan = wall_clock64() - ts0; }
#else
    if (blockIdx.x < NSCAN) rwkv_scan(p, lds);
#endif
    unsigned* ctl = (unsigned*)(p.ws + WS_SMALL + 2048); LAS int* itemw = (LAS int*)(lds + NS_ITEM);
    for (;;) {
        __syncthreads();
        if (threadIdx.x == 0) *itemw = (int)atomicAdd(ctl, 1u);
        __syncthreads();
        const int item = *itemw;
        if (item >= 1024) break;
        nsa_item(p, lds, item);
    }
}
__device__ __forceinline__ void phase_rwfin(const Params& p) {
    unsigned char* ws = p.ws; const int lane = threadIdx.x & 63, gw = blockIdx.x * 8 + (threadIdx.x >> 6), NGW = gridDim.x * 8, li = lane & 15, R = lane >> 4;
    const bf16_t* U = (const bf16_t*)(ws + WS_U); const bf16_t* RWX = (const bf16_t*)((unsigned char*)p.out + DO_RWX);
    const bf16_t* YB = (const bf16_t*)(ws + WS_YB); bf16_t* Y = (bf16_t*)(ws + WS_HB);
    const float* mu = p.in[10];
    for (int it = gw; it < S * 4; it += NGW) { const int t = it >> 2, h = (it & 3) * 4 + R, cix = h * 64 + 4 * li;
        const bf16_t* u = U + (size_t)t * UC + 2584 + cix;
        float y[4]; up4(*(const u32x2*)(YB + (size_t)t * 1024 + cix), y);
        const float mean = row16_sum((y[0] + y[1]) + (y[2] + y[3])) * (1.0f / 64.f); float var = 0.f;
#pragma unroll
        for (int i = 0; i < 4; ++i) { y[i] -= mean; var += y[i] * y[i]; }
        const float rstd = rsqrtf(row16_sum(var) * (1.0f / 64.f) + 64e-5f);
        float rc[4], kc[4], vc[4], rp[4] = {0.f, 0.f, 0.f, 0.f}, kp[4] = {0.f, 0.f, 0.f, 0.f}, vp[4] = {0.f, 0.f, 0.f, 0.f}, a[4], g[4];
        up4(*(const u32x2*)u, rc); up4(*(const u32x2*)(u + 1024), kc); up4(*(const u32x2*)(u + 2048), vc);
        if (t > 0) { up4(*(const u32x2*)(u - UC), rp); up4(*(const u32x2*)(u + 1024 - UC), kp); up4(*(const u32x2*)(u + 2048 - UC), vp); }
        up4(*(const u32x2*)(RWX + (size_t)t * 3072 + 1024 + cix), a); up4(*(const u32x2*)(RWX + (size_t)t * 3072 + 2048 + cix), g);
        const f32x4 mr = *(const f32x4*)(mu + cix), mk = *(const f32x4*)(mu + 1024 + cix), mv = *(const f32x4*)(mu + 2048 + cix), ka = *(const f32x4*)(p.in[17] + cix), rk = *(const f32x4*)(p.in[18] + cix);
        const f32x4 lw = *(const f32x4*)(p.in[19] + cix), lb = *(const f32x4*)(p.in[20] + cix);
        float bsum = 0.f, v[4];
#pragma unroll
        for (int i = 0; i < 4; ++i) { const float r = rc[i] + (rp[i] - rc[i]) * mr[i], k = kc[i] + (kp[i] - kc[i]) * mk[i]; v[i] = vc[i] + (vp[i] - vc[i]) * mv[i];
            bsum += r * (k * (1.0f + (a[i] - 1.0f) * ka[i])) * rk[i]; }
        bsum = row16_sum(bsum);
        float o[4];
#pragma unroll
        for (int i = 0; i < 4; ++i) o[i] = (y[i] * rstd * lw[i] + lb[i] + bsum * v[i]) * g[i];
        u32x2 w; w.x = cvt_pk_bf16(o[0], o[1]); w.y = cvt_pk_bf16(o[2], o[3]); *(u32x2*)(Y + (size_t)t * DM + 1024 + cix) = w;
    }
}
__device__ __forceinline__ float silu_f(float x) { return x * sigm(x); }
__device__ __forceinline__ float gelu_tanh(float x) { const float u = 0.7978845608028654f * (x + 0.044715f * x * x * x); return 0.5f * x * (1.0f + ftanh(u)); }
__device__ __forceinline__ void phase_conv(const Params& p) {
    unsigned char* ws = p.ws; const bf16_t* U = (const bf16_t*)(ws + WS_U); bf16_t* XCB = (bf16_t*)(ws + WS_HB);
    const float *cw = p.in[23], *cbias = p.in[24];
    for (int idx = blockIdx.x * 512 + threadIdx.x; idx < S * 256; idx += gridDim.x * 512) { const int t = idx >> 8, c = (idx & 255) * 4; float acc[4];
#pragma unroll
        for (int i = 0; i < 4; ++i) acc[i] = cbias[c + i];
#pragma unroll
        for (int w = 0; w < 4; ++w) { const int tt = t - 3 + w; if (tt < 0) continue; const u32x2 x = *(const u32x2*)(U + (size_t)tt * UC + 1024 + c);
            acc[0] += cw[w * 1024 + c] * bf2f((bf16_t)(x.x & 0xffff)); acc[1] += cw[w * 1024 + c + 1] * bf2f((bf16_t)(x.x >> 16)); acc[2] += cw[w * 1024 + c + 2] * bf2f((bf16_t)(x.y & 0xffff)); acc[3] += cw[w * 1024 + c + 3] * bf2f((bf16_t)(x.y >> 16)); }
        u32x2 o; o.x = cvt_pk_bf16(acc[0], acc[1]); o.y = cvt_pk_bf16(acc[2], acc[3]); *(u32x2*)(XCB + (size_t)t * 1024 + c) = o; }
}
__device__ __forceinline__ void lru_chunk(const Params& p, bool apply) {
    unsigned char* ws = p.ws;
    bf16_t* RG = (bf16_t*)((unsigned char*)p.out + DO_RG); const bf16_t* XCB = (const bf16_t*)(ws + WS_HB);
    float* LP = (float*)(ws + WS_LRUP); float* LH = (float*)(ws + WS_LRUH); const bf16_t* U = (const bf16_t*)(ws + WS_U); bf16_t* Y = (bf16_t*)(ws + WS_HB);
    for (int gid = blockIdx.x * 512 + threadIdx.x; gid < 256 * 512; gid += gridDim.x * 512) {
        const int c = gid >> 9, ch = (gid & 511) * 2;
        float h0 = 0.f, h1 = 0.f, sl0 = 0.f, sl1 = 0.f;
        if (apply) { h0 = LH[c * 1024 + ch]; h1 = LH[c * 1024 + ch + 1]; }
        const float ba0 = p.in[26][ch], ba1 = p.in[26][ch + 1], bx0 = p.in[28][ch], bx1 = p.in[28][ch + 1], sp0 = softplusf(-p.in[29][ch]), sp1 = softplusf(-p.in[29][ch + 1]);
#pragma unroll 4
        for (int i = 0; i < 64; ++i) { const size_t t = (size_t)c * 64 + i; u32x2* pp = (u32x2*)(RG + t * 2048 + 2 * ch); const u32x2 x = *pp;
            float la0, b0, la1, b1;
            if (!apply) { const unsigned xc2 = *(const unsigned*)(XCB + t * 1024 + ch);
                const float r0 = sigm(bf2f((bf16_t)(x.x & 0xffff)) + ba0), i0 = sigm(bf2f((bf16_t)(x.x >> 16)) + bx0), r1 = sigm(bf2f((bf16_t)(x.y & 0xffff)) + ba1), i1 = sigm(bf2f((bf16_t)(x.y >> 16)) + bx1);
                la0 = -8.f * r0 * sp0; la1 = -8.f * r1 * sp1;
                b0 = sqrtf(fmaxf(1.0f - fexp(2.f * la0), 0.f)) * i0 * bf2f((bf16_t)(xc2 & 0xffff)); b1 = sqrtf(fmaxf(1.0f - fexp(2.f * la1), 0.f)) * i1 * bf2f((bf16_t)(xc2 >> 16));
                u32x2 o; o.x = cvt_pk_bf16(la0, b0); o.y = cvt_pk_bf16(la1, b1); *pp = o;
                la0 = bf2f((bf16_t)(o.x & 0xffff)); b0 = bf2f((bf16_t)(o.x >> 16)); la1 = bf2f((bf16_t)(o.y & 0xffff)); b1 = bf2f((bf16_t)(o.y >> 16)); }
            else { la0 = bf2f((bf16_t)(x.x & 0xffff)); b0 = bf2f((bf16_t)(x.x >> 16)); la1 = bf2f((bf16_t)(x.y & 0xffff)); b1 = bf2f((bf16_t)(x.y >> 16)); }
            h0 = fexp(la0) * h0 + b0; h1 = fexp(la1) * h1 + b1; sl0 += la0; sl1 += la1;
            if (apply) { const unsigned gi = *(const unsigned*)(U + t * UC + ch); *(unsigned*)(Y + t * DM + ch) = cvt_pk_bf16(h0 * gelu_tanh(bf2f((bf16_t)(gi & 0xffff))), h1 * gelu_tanh(bf2f((bf16_t)(gi >> 16)))); } }
        if (!apply) { LP[c * 1024 + ch] = fexp(sl0); LP[c * 1024 + ch + 1] = fexp(sl1); LH[c * 1024 + ch] = h0; LH[c * 1024 + ch + 1] = h1; }
    }
}
__device__ __forceinline__ void lru_carry(const Params& p, int chn) {
    float* LP = (float*)(p.ws + WS_LRUP); float* LH = (float*)(p.ws + WS_LRUH); float carry = 0.f;
    for (int c0 = 0; c0 < 256; c0 += 8) { float pv[8], hv[8];
#pragma unroll
        for (int i = 0; i < 8; ++i) { pv[i] = LP[(c0 + i) * 1024 + chn]; hv[i] = LH[(c0 + i) * 1024 + chn]; }
#pragma unroll
        for (int i = 0; i < 8; ++i) { LH[(c0 + i) * 1024 + chn] = carry; carry = pv[i] * carry + hv[i]; } }
}
constexpr int HG_BC = 0, HG_KT = 32768, HG_VT = 51200;
constexpr int HC_QIN = 32768, HC_QI = 50176, HC_KI = 67584, HC_VT = 111104, HC_ATT = 129536, HC_RED = 138752;
__device__ __forceinline__ void hg_bcum(const Params& p, LAS unsigned char* lds, int c, int h, float lower, int k, int q4) {
    const bf16_t* U = (const bf16_t*)(p.ws + WS_U); LAS float* BC = (LAS float*)(lds + HG_BC); LAS float* TOT = (LAS float*)(lds + 138752);
    float cs[16]; bf16_t fr[16];
#pragma unroll
    for (int i = 0; i < 16; ++i) fr[i] = U[(size_t)(64 * c + q4 * 16 + i) * UC + 3072 + 128 * h + k];
    float run = 0.f;
#pragma unroll
    for (int i = 0; i < 16; ++i) { run += flog(lower + (1.0f - lower) * sigm(bf2f(fr[i]))); cs[i] = run; }
    TOT[q4 * 128 + k] = run;
    __syncthreads();
    float off = 0.f;
#pragma unroll
    for (int q = 0; q < 3; ++q) off += (q < q4) ? TOT[q * 128 + k] : 0.f;
#pragma unroll
    for (int i = 0; i < 16; ++i) BC[(q4 * 16 + i) * 128 + k] = cs[i] + off;
    __syncthreads();
}
__device__ __forceinline__ void hgrn_a(const Params& p, LAS unsigned char* lds) {
    unsigned char* ws = p.ws; const int tid = threadIdx.x, lane = tid & 63, w = tid >> 6, k = tid & 127, q4 = tid >> 7, li = lane & 15, quad = lane >> 4;
    const bf16_t* U = (const bf16_t*)(ws + WS_U); bf16_t* HGS = (bf16_t*)((unsigned char*)p.out + DO_HGS); float* HGD = (float*)(ws + WS_HGD);
    LAS float* BC = (LAS float*)(lds + HG_BC);
    for (int item = blockIdx.x; item < 2048; item += gridDim.x) { const int c = item >> 3, h = item & 7;
        const float lower = sigm(p.in[30][1024 + 128 * h + k] - p.in[30][128 * h + k]);
        hg_bcum(p, lds, c, h, lower, k, q4);
        const float blast = BC[63 * 128 + k];
#pragma unroll 8
        for (int t = q4 * 16; t < q4 * 16 + 16; ++t) { const bf16_t* u = U + (size_t)(64 * c + t) * UC + 128 * h + k;
            const float forget = lower + (1.0f - lower) * sigm(bf2f(u[3072]));
            *(LAS bf16_t*)(lds + HG_KT + (k * 72 + t) * 2) = f2bf((1.0f - forget) * fexp(blast - BC[t * 128 + k]));
            *(LAS bf16_t*)(lds + HG_VT + (k * 72 + t) * 2) = u[4096]; }
        if (tid < 128) HGD[(size_t)(c * 8 + h) * 128 + k] = fexp(blast);
        __syncthreads();
        bf16x8 av[2];
#pragma unroll
        for (int ks = 0; ks < 2; ++ks) av[ks] = *(const LAS bf16x8*)(lds + HG_VT + (16 * w + li) * 144 + (32 * ks + 8 * quad) * 2);
#pragma unroll
        for (int kt = 0; kt < 8; ++kt) { f32x4 acc = {0.f, 0.f, 0.f, 0.f};
#pragma unroll
            for (int ks = 0; ks < 2; ++ks) { const bf16x8 b = *(const LAS bf16x8*)(lds + HG_KT + (16 * kt + li) * 144 + (32 * ks + 8 * quad) * 2); acc = MFMA16(av[ks], b, acc); }
#pragma unroll
            for (int r = 0; r < 4; ++r) HGS[((size_t)(c * 8 + h) * 128 + 16 * w + 4 * quad + r) * 128 + 16 * kt + li] = f2bf(acc[r]); }
        __syncthreads();
    }
}
__device__ __forceinline__ void hgrn_b(const Params& p) {
    for (int e = blockIdx.x * 512 + threadIdx.x; e < 65536; e += gridDim.x * 512) {
    unsigned* HG = (unsigned*)((unsigned char*)p.out + DO_HGS); const float* HGD = (const float*)(p.ws + WS_HGD);
    const int h = e >> 13, k = (e & 63) * 2; float r0 = 0.f, r1 = 0.f;
    for (int c0 = 0; c0 < 256; c0 += 8) { unsigned lv[8]; float d0[8], d1[8];
#pragma unroll
        for (int i = 0; i < 8; ++i) { lv[i] = HG[(size_t)(c0 + i) * 65536 + e]; d0[i] = HGD[(size_t)((c0 + i) * 8 + h) * 128 + k]; d1[i] = HGD[(size_t)((c0 + i) * 8 + h) * 128 + k + 1]; }
#pragma unroll
        for (int i = 0; i < 8; ++i) { HG[(size_t)(c0 + i) * 65536 + e] = cvt_pk_bf16(r0, r1); r0 = d0[i] * r0 + bf2f((bf16_t)(lv[i] & 0xffff)); r1 = d1[i] * r1 + bf2f((bf16_t)(lv[i] >> 16)); } }
    }
}
__device__ __forceinline__ void hgrn_c(const Params& p, LAS unsigned char* lds) {
    unsigned char* ws = p.ws; const int tid = threadIdx.x, lane = tid & 63, w = tid >> 6, k = tid & 127, q4 = tid >> 7, li = lane & 15, quad = lane >> 4;
    const bf16_t* U = (const bf16_t*)(ws + WS_U); const bf16_t* HGS = (const bf16_t*)((unsigned char*)p.out + DO_HGS); bf16_t* Y = (bf16_t*)(ws + WS_HB);
    LAS float* BC = (LAS float*)(lds + HG_BC); LAS float* RED = (LAS float*)(lds + HC_RED);
    for (int item = blockIdx.x; item < 2048; item += gridDim.x) { const int c = item >> 3, h = item & 7;
        const float lower = sigm(p.in[30][1024 + 128 * h + k] - p.in[30][128 * h + k]);
        hg_bcum(p, lds, c, h, lower, k, q4);
        for (int i = tid; i < 576; i += 512) *(LAS u32x4*)(lds + HC_ATT + i * 16) = (u32x4){0u, 0u, 0u, 0u};
#pragma unroll 4
        for (int t = q4 * 16; t < q4 * 16 + 16; ++t) { const bf16_t* u = U + (size_t)(64 * c + t) * UC + 128 * h + k;
            const float bc = BC[t * 128 + k], bref = q4 > 0 ? BC[(16 * q4 - 1) * 128 + k] : 0.f;
            const float qv = silu_f(bf2f(u[2048])), kh = 1.0f - (lower + (1.0f - lower) * sigm(bf2f(u[3072])));
            *(LAS bf16_t*)(lds + HC_QIN + (t * 136 + k) * 2) = f2bf(qv * fexp(bc));
            *(LAS bf16_t*)(lds + HC_QI + (t * 136 + k) * 2) = f2bf(qv * fexp(bc - bref));
            *(LAS bf16_t*)(lds + HC_VT + (k * 72 + t) * 2) = u[4096];
            for (int I = q4; I < 4; ++I) { const float br = I > 0 ? BC[(16 * I - 1) * 128 + k] : 0.f; const int ro = (I == 0 ? 0 : (I == 1 ? 16 : (I == 2 ? 48 : 96)));
                *(LAS bf16_t*)(lds + HC_KI + ((ro + t) * 136 + k) * 2) = f2bf(kh * fexp(fminf(br - bc, 80.f))); } }
        __syncthreads();
        for (int ti = w; ti < 10; ti += 8) {
            const int I = ti < 1 ? 0 : (ti < 3 ? 1 : (ti < 6 ? 2 : 3)), J = ti - (I == 0 ? 0 : (I == 1 ? 1 : (I == 2 ? 3 : 6))), ro = (I == 0 ? 0 : (I == 1 ? 16 : (I == 2 ? 48 : 96)));
            f32x4 acc = {0.f, 0.f, 0.f, 0.f};
#pragma unroll
            for (int ks = 0; ks < 4; ++ks) { const bf16x8 a = *(const LAS bf16x8*)(lds + HC_QI + (16 * I + li) * 272 + (32 * ks + 8 * quad) * 2), b = *(const LAS bf16x8*)(lds + HC_KI + (ro + 16 * J + li) * 272 + (32 * ks + 8 * quad) * 2); acc = MFMA16(a, b, acc); }
#pragma unroll
            for (int r = 0; r < 4; ++r) { const int t = 16 * I + 4 * quad + r, s = 16 * J + li; *(LAS bf16_t*)(lds + HC_ATT + (t * 72 + s) * 2) = f2bf(s <= t ? acc[r] : 0.f); } }
        __syncthreads();
        f32x4 o[4];
#pragma unroll
        for (int tt = 0; tt < 4; ++tt) o[tt] = (f32x4){0.f, 0.f, 0.f, 0.f};
#pragma unroll
        for (int ks = 0; ks < 4; ++ks) { const bf16x8 a = *(const bf16x8*)(HGS + ((size_t)(c * 8 + h) * 128 + 16 * w + li) * 128 + 32 * ks + 8 * quad);
#pragma unroll
            for (int tt = 0; tt < 4; ++tt) { const bf16x8 b = *(const LAS bf16x8*)(lds + HC_QIN + (16 * tt + li) * 272 + (32 * ks + 8 * quad) * 2); o[tt] = MFMA16(a, b, o[tt]); } }
#pragma unroll
        for (int ks = 0; ks < 2; ++ks) { const bf16x8 a = *(const LAS bf16x8*)(lds + HC_VT + (16 * w + li) * 144 + (32 * ks + 8 * quad) * 2);
#pragma unroll
            for (int tt = 0; tt < 4; ++tt) { const bf16x8 b = *(const LAS bf16x8*)(lds + HC_ATT + (16 * tt + li) * 144 + (32 * ks + 8 * quad) * 2); o[tt] = MFMA16(a, b, o[tt]); } }
#pragma unroll
        for (int tt = 0; tt < 4; ++tt) { float sq = (o[tt][0] * o[tt][0] + o[tt][1] * o[tt][1]) + (o[tt][2] * o[tt][2] + o[tt][3] * o[tt][3]); sq += __shfl_xor(sq, 16); sq += __shfl_xor(sq, 32); if (quad == 0) RED[w * 64 + 16 * tt + li] = sq; }
        __syncthreads();
#pragma unroll
        for (int tt = 0; tt < 4; ++tt) { float tot = 0.f;
#pragma unroll
            for (int ww = 0; ww < 8; ++ww) tot += RED[ww * 64 + 16 * tt + li];
            const float rinv = rsqrtf(tot * (1.0f / 128.f) + 1e-6f); const int t = 64 * c + 16 * tt + li, vcol = 128 * h + 16 * w + 4 * quad;
            const u32x2 gp = *(const u32x2*)(U + (size_t)t * UC + 5120 + vcol); const f32x4 ng = *(const f32x4*)(p.in[31] + vcol);
            const float g0 = bf2f((bf16_t)(gp.x & 0xffff)), g1 = bf2f((bf16_t)(gp.x >> 16)), g2 = bf2f((bf16_t)(gp.y & 0xffff)), g3 = bf2f((bf16_t)(gp.y >> 16));
            u32x2 ov; ov.x = cvt_pk_bf16(o[tt][0] * rinv * ng[0] * silu_f(g0), o[tt][1] * rinv * ng[1] * silu_f(g1)); ov.y = cvt_pk_bf16(o[tt][2] * rinv * ng[2] * silu_f(g2), o[tt][3] * rinv * ng[3] * silu_f(g3));
            *(u32x2*)(Y + (size_t)t * DM + 1024 + vcol) = ov; }
        __syncthreads();
    }
}
#ifndef MASK
#define MASK 0xFFFFFFFF
#endif
#define PH(n) (((MASK) >> (n)) & 1)
template <class T> __device__ __forceinline__ T* uni_ptr(T* ptr) { const unsigned long long v = (unsigned long long)ptr; const unsigned lo = __builtin_amdgcn_readfirstlane((unsigned)v), hi = __builtin_amdgcn_readfirstlane((unsigned)(v >> 32)); return (T*)(((unsigned long long)hi << 32) | lo); }
__global__ void __launch_bounds__(512) mk_forward(const Params kp) {
    extern __shared__ __attribute__((aligned(16))) unsigned char shm[];
    LAS unsigned char* lds = (LAS unsigned char*)shm;
    unsigned char* ws = kp.ws; unsigned char* dob = (unsigned char*)kp.out; const int lo = kp.ph_lo, hi = kp.ph_hi;
    { LAS Params* lp = (LAS Params*)(lds + LDS_BYTES - 512);
      if (threadIdx.x < 4) ((LAS unsigned*)(lds + LDS_BYTES - 512 + 320))[threadIdx.x] = 0u;
      __syncthreads();
      if (threadIdx.x == 0) {
#pragma unroll
          for (int i = 0; i < 32; ++i) lp->in[i] = kp.in[i];
          lp->out = (float*)dob; lp->ws = ws; lp->ph_lo = lo; lp->ph_hi = hi; }
      __syncthreads(); }
    const Params& p = *(const Params*)(shm + LDS_BYTES - 512);
    bf16_t *WIN = (bf16_t*)(ws + WS_WIN), *WOUT = (bf16_t*)(ws + WS_WOUT), *W1 = (bf16_t*)(ws + WS_W1), *W2 = (bf16_t*)(ws + WS_W2), *HB = (bf16_t*)(ws + WS_HB), *UB = (bf16_t*)(ws + WS_U), *ZB = (bf16_t*)(ws + WS_Z);
    float* X2 = (float*)(ws + WS_X2);
#ifdef PROBE_MASK
    unsigned long long t_prev = wall_clock64(), t_acc = 0ull;
#define PROBE_TICK(k) { const unsigned long long t_now = wall_clock64(); if ((k) > 0 && ((PROBE_MASK >> ((k) - 1)) & 1)) t_acc += t_now - t_prev; t_prev = t_now; }
#else
#define PROBE_TICK(k)
#endif
    XcdBarrier xb; xb.bar = (unsigned*)(ws + WS_SMALL + 4096); xb.x = 0u; xb.st = (volatile LAS unsigned*)(lds + LDS_BYTES - 512 + 320);
    bool posted = false;
#define SEAM(k) { if (!posted) { cg::this_grid().sync(); xb = xcd_barrier_post((unsigned*)(ws + WS_SMALL + 4096), (volatile LAS unsigned*)(lds + LDS_BYTES - 512 + 320)); posted = true; } else xcd_barrier(xb); }
#define PHASE(k, ...) if (PH(k) && lo <= (k) && (k) < hi) { if ((k) > lo) SEAM(k) PROBE_TICK(k) __VA_ARGS__ }
    PHASE(0, phase_prep0(p, lds);)
    PHASE(1, run_gemm(lds, HB, DM, WIN, DM, S, UC, DM, EpiBf16<0>{UB, UC});)
    PHASE(2, phase_tok0(p, lds);)
    PHASE(3, run_gemm(lds, (const bf16_t*)(ws + WS_ALORA), 512, (const bf16_t*)(ws + WS_LORA), 512, S, 3072, 512, EpiBf16<0>{(bf16_t*)(dob + DO_RWX), 3072});)
    if (PH(3) && lo <= 3 && 3 < hi) { run_gemm(lds, (const bf16_t*)(ws + WS_KCVC), 2048, (const bf16_t*)(ws + WS_CMPW), 4096, 4096, 256, 4096, EpiF32{(float*)(ws + WS_CMPC), 256}); }
    PHASE(4, phase_cmpfin(p, lds);)
    unsigned long long scan_t = 0ull;
    PHASE(5, phase_mix0(p, lds, scan_t);)
    PHASE(6, phase_rwfin(p);)
    PHASE(7, run_gemm(lds, HB, DM, WOUT, DM, S, DM, DM, EpiResid{uni_ptr(p.in[0]), kp.out});)
    PHASE(8, rmsnorm_rows(p.out, p.in[2], HB, S);)
    PHASE(9, run_gemm(lds, HB, DM, W1, DM, 8192, FF, DM, EpiBf16<1>{ZB, FF});)
    PHASE(10, run_gemm(lds, ZB, FF, W2, FF, 8192, DM, FF, EpiResid{kp.out, X2});)
    PHASE(11, run_gemm(lds, HB + (size_t)8192 * DM, DM, W1, DM, 8192, FF, DM, EpiBf16<1>{ZB, FF});)
    PHASE(12, run_gemm(lds, ZB, FF, W2, FF, 8192, DM, FF, EpiResid{kp.out + (size_t)8192 * DM, X2 + (size_t)8192 * DM});)
    PHASE(13, phase_prep1(p, lds);)
    PHASE(14, run_gemm(lds, HB, DM, WIN, DM, S, UC, DM, EpiBf16<0>{UB, UC});)
    PHASE(15, phase_conv(p);)
    PHASE(16, run_gemm(lds, HB, 1024, (const bf16_t*)(ws + WS_LRUG), 1024, S, 2048, 1024, EpiBf16<0>{(bf16_t*)(dob + DO_RG), 2048});)
    PHASE(17, lru_chunk(p, false); hgrn_a(p, lds);)
    PHASE(18, if (blockIdx.x >= gridDim.x - 2) lru_carry(p, (int)(blockIdx.x - (gridDim.x - 2)) * 512 + (int)threadIdx.x); else hgrn_b(p);)
    PHASE(19, lru_chunk(p, true); hgrn_c(p, lds);)
    PHASE(20, run_gemm(lds, HB, DM, WOUT, DM, S, DM, DM, EpiResid{X2, kp.out});)
    PHASE(21, rmsnorm_rows(p.out, p.in[2] + DM, HB, S);)
    PHASE(22, run_gemm(lds, HB, DM, W1, DM, 8192, FF, DM, EpiBf16<1>{ZB, FF});)
    PHASE(23, run_gemm(lds, ZB, FF, W2, FF, 8192, DM, FF, EpiResid{kp.out, kp.out});)
    PHASE(24, run_gemm(lds, HB + (size_t)8192 * DM, DM, W1, DM, 8192, FF, DM, EpiBf16<1>{ZB, FF});)
    PHASE(25, run_gemm(lds, ZB, FF, W2, FF, 8192, DM, FF, EpiResid{kp.out + (size_t)8192 * DM, kp.out + (size_t)8192 * DM});)
#undef PHASE
#ifdef PROBE_SYNCS
    for (int i = 0; i < PROBE_SYNCS; ++i) xcd_barrier(xb);
#endif
#ifdef PROBE_MASK
    if (blockIdx.x == 0) { __syncthreads(); PROBE_TICK(26)
#ifdef PROBE_SCAN
        t_acc = scan_t;
#endif
        const unsigned long long t_end = wall_clock64(); while (wall_clock64() - t_end < PROBE_MULT * t_acc) __builtin_amdgcn_s_sleep(32); }
#endif
}

extern "C" void kernel_launch(void* const* d_in, const int* in_sizes, int n_in, void* d_out, int out_size, void* d_ws, size_t ws_size, hipStream_t stream) {
    static int grid = 0;
    if (grid == 0) {
        if (n_in != 32 || out_size != S * DM || ws_size < WS_END) { fprintf(stderr, "kernel_launch: unexpected problem (n_in %d out %d ws %zu)\n", n_in, out_size, ws_size); grid = -1; return; }
        int dev = 0, cus = 0, per_cu = 0;
        hipGetDevice(&dev); hipDeviceGetAttribute(&cus, hipDeviceAttributeMultiprocessorCount, dev);
        if (hipFuncSetAttribute((const void*)mk_forward, hipFuncAttributeMaxDynamicSharedMemorySize, LDS_BYTES) != hipSuccess) { fprintf(stderr, "kernel_launch: hipFuncSetAttribute failed\n"); grid = -1; return; }
        if (hipOccupancyMaxActiveBlocksPerMultiprocessor(&per_cu, (const void*)mk_forward, 512, LDS_BYTES) != hipSuccess || per_cu < 1) { fprintf(stderr, "kernel_launch: occupancy query says %d\n", per_cu); per_cu = 1; }
        (void)hipGetLastError();
        grid = cus * 1;
        fprintf(stderr, "kernel_launch: cus %d per_cu %d grid %d\n", cus, per_cu, grid);
    }
    if (grid < 0) return;
    Params p{};
    for (int i = 0; i < 32; ++i) p.in[i] = (const float*)d_in[i];
    p.out = (float*)d_out; p.ws = (unsigned char*)d_ws;
#if MK_PER_PHASE
    for (int ph = 0; ph < NPHASE; ++ph) { p.ph_lo = ph; p.ph_hi = ph + 1; hipLaunchKernelGGL(mk_forward, dim3(grid), dim3(512), LDS_BYTES, stream, p); }
#else
    p.ph_lo = 0; p.ph_hi = NPHASE;
    void* args[] = {(void*)&p};
    hipError_t e = hipLaunchCooperativeKernel((const void*)mk_forward, dim3(grid), dim3(512), args, LDS_BYTES, stream);
    if (e != hipSuccess) fprintf(stderr, "cooperative launch failed: %s (grid %d)\n", hipGetErrorString(e), grid);
#endif
}
```
